# Optimizing an MI355X kernel written in HIP

```python
import math, functools
import jax, jax.numpy as jnp
from jax import lax
import numpy as np

D_MODEL = 1024
BATCH = 2
SEQ = 8192
DEPTH = 4

N_MIXERS = 3
N_LAYERS_CONV = len(range(0, DEPTH, N_MIXERS))
N_LAYERS_FOX = len(range(1, DEPTH, N_MIXERS))
N_LAYERS_SSD = len(range(2, DEPTH, N_MIXERS))

RMS_EPS = 1e-6

D_FF = -(-8 * D_MODEL // (3 * 256)) * 256

CONV_WIDTH = 3

ATTN_HEAD_DIM = 64
ATTN_HEADS = D_MODEL // ATTN_HEAD_DIM
ATTN_WIDTH = ATTN_HEADS * ATTN_HEAD_DIM
Q_BLOCK = 128
FOX_IN = 3 * ATTN_WIDTH + ATTN_HEADS

SSM_EXPAND = 2
SSM_D_INNER = SSM_EXPAND * D_MODEL
SSM_HEAD_DIM = 64
SSM_HEADS = SSM_D_INNER // SSM_HEAD_DIM
SSM_GROUPS = 8
SSM_HEADS_PER_GROUP = SSM_HEADS // SSM_GROUPS
SSM_STATE = 128
SSM_CONV = 4
SSM_CHUNK = 128
SSM_CONV_DIM = SSM_D_INNER + 2 * SSM_GROUPS * SSM_STATE
SSM_IN = SSM_D_INNER + SSM_CONV_DIM + SSM_HEADS

kernel_name = "hybrid_conv_fox_ssd_trunk"


def rms_norm(x, w, eps=RMS_EPS):
    xf = x.astype(jnp.float32)
    y = xf * lax.rsqrt(jnp.mean(xf * xf, axis=-1, keepdims=True) + eps)
    return (y * w.astype(jnp.float32)).astype(x.dtype)


def causal_depthwise_conv(u, w):
    k_w = w.shape[0]
    seq = u.shape[1]
    up = jnp.pad(u, ((0, 0), (k_w - 1, 0), (0, 0)))
    out = up[:, 0:seq] * w[0]
    for k in range(1, k_w):
        out = out + up[:, k:k + seq] * w[k]
    return out


def swiglu_ffn(h, w_gu, w_down):
    g, u = jnp.split(h @ w_gu, 2, axis=-1)
    return (jax.nn.silu(g) * u) @ w_down


def short_conv_mixer(h, w_in, conv_w, w_out):
    b_gate, c_gate, v = jnp.split(h @ w_in, 3, axis=-1)
    u = causal_depthwise_conv(c_gate * v, conv_w)
    return (b_gate * u) @ w_out


def forgetting_attention(h, w_in, b_f, q_gain, k_gain, w_out):
    bsz, seq, _ = h.shape
    proj = h @ w_in
    q, k, v, f_logit = jnp.split(proj, [ATTN_WIDTH, 2 * ATTN_WIDTH, 3 * ATTN_WIDTH], axis=-1)
    q = rms_norm(q.reshape(bsz, seq, ATTN_HEADS, ATTN_HEAD_DIM), q_gain).astype(jnp.float32)
    k = rms_norm(k.reshape(bsz, seq, ATTN_HEADS, ATTN_HEAD_DIM), k_gain).astype(jnp.float32)
    v = v.reshape(bsz, seq, ATTN_HEADS, ATTN_HEAD_DIM).astype(jnp.float32)
    log_f = jax.nn.log_sigmoid((f_logit + b_f).astype(jnp.float32))
    cum = jnp.cumsum(log_f, axis=1)
    cum_k = jnp.transpose(cum, (0, 2, 1))[:, :, None, :]
    n_blk = seq // Q_BLOCK
    q_blk = jnp.moveaxis(q.reshape(bsz, n_blk, Q_BLOCK, ATTN_HEADS, ATTN_HEAD_DIM), 1, 0)
    cum_q = jnp.moveaxis(cum.reshape(bsz, n_blk, Q_BLOCK, ATTN_HEADS), 1, 0)
    key_pos = jnp.arange(seq)
    scale = ATTN_HEAD_DIM ** -0.5

    def attend(args):
        qb, cq, bi = args
        logits = jnp.einsum('bqhd,bkhd->bhqk', qb, k) * scale
        logits = logits + jnp.transpose(cq, (0, 2, 1))[..., None] - cum_k
        q_pos = bi * Q_BLOCK + jnp.arange(Q_BLOCK)
        causal = q_pos[:, None] >= key_pos[None, :]
        logits = jnp.where(causal, logits, -jnp.inf)
        p = jax.nn.softmax(logits, axis=-1)
        return jnp.einsum('bhqk,bkhd->bqhd', p, v)

    out = lax.map(attend, (q_blk, cum_q, jnp.arange(n_blk)))
    out = jnp.moveaxis(out, 0, 1).reshape(bsz, seq, ATTN_WIDTH).astype(h.dtype)
    return out @ w_out


def ssd_chunked(xs, dt, a, b_m, c_m):
    bsz, seq = xs.shape[:2]
    nc = seq // SSM_CHUNK
    L, G, K, P, N = SSM_CHUNK, SSM_GROUPS, SSM_HEADS_PER_GROUP, SSM_HEAD_DIM, SSM_STATE
    x = xs.reshape(bsz, nc, L, G, K, P)
    dtc = dt.reshape(bsz, nc, L, G, K)
    bc = b_m.reshape(bsz, nc, L, G, N)
    cc = c_m.reshape(bsz, nc, L, G, N)
    acum = jnp.cumsum(dtc * a.reshape(G, K), axis=2)
    seg = acum[:, :, :, None] - acum[:, :, None]
    mask = jnp.tril(jnp.ones((L, L), dtype=bool))[:, :, None, None]
    decay = jnp.exp(jnp.where(mask, seg, -jnp.inf))
    cb = jnp.einsum('bclgn,bcsgn->bclsg', cc, bc)
    w = cb[..., None] * decay * dtc[:, :, None]
    y_diag = jnp.einsum('bclsgk,bcsgkp->bclgkp', w, x)
    decay_states = jnp.exp(acum[:, :, -1:] - acum)
    states = jnp.einsum('bclgn,bclgk,bclgkp->bcgkpn', bc, decay_states * dtc, x)
    chunk_decay = jnp.exp(acum[:, :, -1])

    def step(hst, inp):
        st, dec = inp
        return dec[..., None, None] * hst + st, hst

    h0 = jnp.zeros((bsz, G, K, P, N), jnp.float32)
    _, prev = lax.scan(step, h0, (jnp.moveaxis(states, 1, 0), jnp.moveaxis(chunk_decay, 1, 0)))
    prev = jnp.moveaxis(prev, 0, 1)
    y_off = jnp.einsum('bclgn,bcgkpn,bclgk->bclgkp', cc, prev, jnp.exp(acum))
    return (y_diag + y_off).reshape(bsz, seq, SSM_HEADS, P)


def mamba2_mixer(h, w_in, conv_w, conv_b, dt_bias, a_log, d_skip, norm_w, w_out):
    bsz, seq, _ = h.shape
    proj = h @ w_in
    z, xbc, dt = jnp.split(proj, [SSM_D_INNER, SSM_D_INNER + SSM_CONV_DIM], axis=-1)
    xbc = jax.nn.silu(causal_depthwise_conv(xbc, conv_w) + conv_b)
    xs, b_m, c_m = jnp.split(xbc, [SSM_D_INNER, SSM_D_INNER + SSM_GROUPS * SSM_STATE], axis=-1)
    xs = xs.reshape(bsz, seq, SSM_HEADS, SSM_HEAD_DIM).astype(jnp.float32)
    b_m = b_m.reshape(bsz, seq, SSM_GROUPS, SSM_STATE).astype(jnp.float32)
    c_m = c_m.reshape(bsz, seq, SSM_GROUPS, SSM_STATE).astype(jnp.float32)
    dt = jax.nn.softplus((dt + dt_bias).astype(jnp.float32))
    a = -jnp.exp(a_log.astype(jnp.float32))
    y = ssd_chunked(xs, dt, a, b_m, c_m) + d_skip.astype(jnp.float32)[:, None] * xs
    y = y.reshape(bsz, seq, SSM_D_INNER) * jax.nn.silu(z.astype(jnp.float32))
    yg = y.reshape(bsz, seq, SSM_GROUPS, SSM_D_INNER // SSM_GROUPS)
    yg = yg * lax.rsqrt(jnp.mean(yg * yg, axis=-1, keepdims=True) + RMS_EPS)
    y = (yg.reshape(bsz, seq, SSM_D_INNER) * norm_w.astype(jnp.float32)).astype(h.dtype)
    return y @ w_out


def setup_inputs(seed: int = 0) -> dict:
    key = jax.random.key(seed)
    ks = iter(jax.random.split(key, 32))
    f32 = jnp.float32

    def normal(shape, scale):
        return jax.random.normal(next(ks), shape, f32) * scale

    def gains(shape):
        return 1.0 + normal(shape, 0.02)

    out_scale = (2.0 * DEPTH) ** -0.5
    nC, nF, nS = N_LAYERS_CONV, N_LAYERS_FOX, N_LAYERS_SSD
    dt0 = jnp.exp(jax.random.uniform(next(ks), (nS, SSM_HEADS), f32, math.log(1e-3), math.log(1e-1)))
    return {
        "x": normal((BATCH, SEQ, D_MODEL), 1.0),
        "mix_norm": gains((DEPTH, D_MODEL)),
        "ffn_norm": gains((DEPTH, D_MODEL)),
        "ffn_w_gu": normal((DEPTH, D_MODEL, 2 * D_FF), D_MODEL ** -0.5),
        "ffn_w_down": normal((DEPTH, D_FF, D_MODEL), D_FF ** -0.5 * out_scale),
        "conv_w_in": normal((nC, D_MODEL, 3 * D_MODEL), D_MODEL ** -0.5),
        "conv_w_dw": normal((nC, CONV_WIDTH, D_MODEL), CONV_WIDTH ** -0.5),
        "conv_w_out": normal((nC, D_MODEL, D_MODEL), D_MODEL ** -0.5 * out_scale),
        "fox_w_in": normal((nF, D_MODEL, FOX_IN), D_MODEL ** -0.5),
        "fox_b_f": 2.0 + normal((nF, ATTN_HEADS), 0.5),
        "fox_q_gain": gains((nF, ATTN_HEAD_DIM)),
        "fox_k_gain": gains((nF, ATTN_HEAD_DIM)),
        "fox_w_out": normal((nF, ATTN_WIDTH, D_MODEL), ATTN_WIDTH ** -0.5 * out_scale),
        "ssd_w_in": normal((nS, D_MODEL, SSM_IN), D_MODEL ** -0.5),
        "ssd_conv_w": normal((nS, SSM_CONV, SSM_CONV_DIM), SSM_CONV ** -0.5),
        "ssd_conv_b": normal((nS, SSM_CONV_DIM), 0.02),
        "ssd_dt_bias": dt0 + jnp.log(-jnp.expm1(-dt0)),
        "ssd_a_log": jnp.log(jax.random.uniform(next(ks), (nS, SSM_HEADS), f32, 1.0, 16.0)),
        "ssd_d": gains((nS, SSM_HEADS)),
        "ssd_norm_w": gains((nS, SSM_D_INNER)),
        "ssd_w_out": normal((nS, SSM_D_INNER, D_MODEL), SSM_D_INNER ** -0.5 * out_scale),
    }


def reference(x, mix_norm, ffn_norm, ffn_w_gu, ffn_w_down,
              conv_w_in, conv_w_dw, conv_w_out,
              fox_w_in, fox_b_f, fox_q_gain, fox_k_gain, fox_w_out,
              ssd_w_in, ssd_conv_w, ssd_conv_b, ssd_dt_bias, ssd_a_log, ssd_d, ssd_norm_w, ssd_w_out):
    for i in range(DEPTH):
        kind, j = i % N_MIXERS, i // N_MIXERS
        h = rms_norm(x, mix_norm[i])
        if kind == 0:
            m = short_conv_mixer(h, conv_w_in[j], conv_w_dw[j], conv_w_out[j])
        elif kind == 1:
            m = forgetting_attention(h, fox_w_in[j], fox_b_f[j], fox_q_gain[j], fox_k_gain[j], fox_w_out[j])
        else:
            m = mamba2_mixer(h, ssd_w_in[j], ssd_conv_w[j], ssd_conv_b[j], ssd_dt_bias[j],
                             ssd_a_log[j], ssd_d[j], ssd_norm_w[j], ssd_w_out[j])
        x = x + m
        x = x + swiglu_ffn(rms_norm(x, ffn_norm[i]), ffn_w_gu[i], ffn_w_down[i])
    return x
```

```cpp
#include <hip/hip_runtime.h>
#include <hip/hip_bf16.h>
#include <cstdio>
#include <cstdint>
#include <cmath>

namespace pg8 {
#define PG8_LAS __attribute__((address_space(3)))
typedef unsigned short bf16_t;
typedef short bf16x8 __attribute__((ext_vector_type(8)));
typedef float f32x4 __attribute__((ext_vector_type(4)));
typedef unsigned u32x4 __attribute__((ext_vector_type(4)));
constexpr int BM = 256, BK = 64, HALF = 128, HTB = HALF * BK * 2  , STAGE_BYTES = 8 * HTB, NXCD = 8, WGM = 8;

__host__ __device__ __forceinline__ int lds_byte(int r, int c) { const int st = (r >> 4) * 2 + (c >> 5), rr = r & 15, cc = c & 31, ob = rr * 64 + cc * 2; return st * 1024 + (ob ^ (((ob >> 9) & 1) << 5)); }
__host__ __device__ __forceinline__ void stage_rc(int b, int& R, int& C) { const int st = b / 1024, sb = b % 1024, swz = sb ^ (((sb >> 9) & 1) << 5); R = (st >> 1) * 16 + swz / 64; C = (st & 1) * 32 + (swz % 64) / 2; }
__host__ __device__ __forceinline__ int perm32(int rho) { const int n = rho >> 4, i = rho & 15; return 8 * (i >> 2) + 4 * n + (i & 3); }

struct Unit { int pm, pn; };
struct Gemm { const bf16_t* A; const bf16_t* Bt; int M, N, K; };

struct StaticOrder {
    int nM, nN, nwg, G, c;
    __host__ __device__ void init(int M, int N, int G_, int c_) { nM = M / BM; nN = N / BM; nwg = nM * nN; G = G_; c = c_; }
    __host__ __device__ bool next(int i, Unit& u) const {
        const long L = (long)i * G + c; if (L >= nwg) return false;
        int wgid = (int)L; { const int q = nwg / NXCD, r = nwg % NXCD, xcd = wgid % NXCD, off = wgid / NXCD; wgid = (xcd < r ? xcd * (q + 1) : r * (q + 1) + (xcd - r) * q) + off; }
        const int nig = WGM * nN, gid = wgid / nig, fm = gid * WGM, gsz = (nM - fm) < WGM ? (nM - fm) : WGM;
        u.pm = fm + ((wgid % nig) % gsz); u.pn = (wgid % nig) / gsz; return true;
    }
    __device__ __forceinline__ void a_ready(const Unit&) const {}
    __device__ __forceinline__ void done(const Unit&) const {}
};


__device__ __forceinline__ unsigned cvt_pk_bf16(float lo, float hi) { unsigned r; asm volatile("v_cvt_pk_bf16_f32 %0, %1, %2" : "=v"(r) : "v"(lo), "v"(hi)); return r; }
__device__ __forceinline__ u32x4 pack8(const f32x4 a, const f32x4 b) { u32x4 w; w.x = cvt_pk_bf16(a[0], a[1]); w.y = cvt_pk_bf16(a[2], a[3]); w.z = cvt_pk_bf16(b[0], b[1]); w.w = cvt_pk_bf16(b[2], b[3]); return w; }
constexpr float RMS_EPS = 1e-6f;
constexpr float LOG2E = 1.4426950408889634f;
__device__ __forceinline__ float row_rstd(const float* ssq, int row) {
    const f32x4* p = (const f32x4*)(ssq + (size_t)row * 16);
    const f32x4 a = p[0], b = p[1], c = p[2], d = p[3];
    const float s = ((a[0] + a[1]) + (a[2] + a[3])) + ((b[0] + b[1]) + (b[2] + b[3])) + ((c[0] + c[1]) + (c[2] + c[3])) + ((d[0] + d[1]) + (d[2] + d[3]));
    return __builtin_amdgcn_rsqf(s * (1.0f / 1024.0f) + RMS_EPS);
}
__device__ __forceinline__ float silu_f(float x) { return x * __builtin_amdgcn_rcpf(1.0f + __builtin_amdgcn_exp2f(-LOG2E * x)); }
__device__ __forceinline__ f32x4 silu4(f32x4 v) { f32x4 o; o[0] = silu_f(v[0]); o[1] = silu_f(v[1]); o[2] = silu_f(v[2]); o[3] = silu_f(v[3]); return o; }

struct EpiConvIn {
    static constexpr bool PERM = true, AFTER_DRAIN = false;
    bf16_t* cv; bf16_t* bb; const float* ssq;
    __device__ __forceinline__ void operator()(const f32x4 (&acc)[2][2][4][2], const Unit& u, int wr, int wc, int fr, int fq) const {
        const int row0 = u.pm * BM + wr * 64 + fr;
#pragma unroll
        for (int ai = 0; ai < 2; ++ai)
#pragma unroll
            for (int m = 0; m < 4; ++m) { const int row = row0 + ai * HALF + m * 16; const float rs = row_rstd(ssq, row);
                if (u.pn < 8) { const float r2 = rs * rs;
                    const f32x4 v0 = acc[ai][0][m][0] * acc[ai][1][m][0] * r2, v1 = acc[ai][0][m][1] * acc[ai][1][m][1] * r2;
                    *(u32x4*)(cv + (size_t)row * 1024 + 128 * u.pn + 32 * wc + 8 * fq) = pack8(v0, v1);
                } else {
#pragma unroll
                    for (int bj = 0; bj < 2; ++bj) *(u32x4*)(bb + (size_t)row * 1024 + 256 * (u.pn - 8) + 128 * bj + 32 * wc + 8 * fq) = pack8(acc[ai][bj][m][0] * rs, acc[ai][bj][m][1] * rs);
                } }
    }
};
struct EpiFoxIn {
    static constexpr bool PERM = true, AFTER_DRAIN = false;
    bf16_t* qkv; const float* ssq; const float* qg; const float* kg; float qscale;
    __device__ __forceinline__ void operator()(const f32x4 (&acc)[2][2][4][2], const Unit& u, int wr, int wc, int fr, int fq) const {
        const int row0 = u.pm * BM + wr * 64 + fr; const int t = u.pn >> 2, head = 4 * (u.pn & 3) + wc;
        bf16_t* base = qkv + (size_t)t * ((size_t)16384 * 1024) + 64 * head + 8 * fq;
        f32x4 g[2][2];
#pragma unroll
        for (int bj = 0; bj < 2; ++bj)
#pragma unroll
            for (int n = 0; n < 2; ++n) { g[bj][n] = (f32x4){1.f, 1.f, 1.f, 1.f};
                if (t < 2) { g[bj][n] = *(const f32x4*)((t == 0 ? qg : kg) + 32 * bj + 8 * fq + 4 * n); if (t == 0) g[bj][n] = g[bj][n] * qscale; } }
#pragma unroll
        for (int ai = 0; ai < 2; ++ai)
#pragma unroll
            for (int m = 0; m < 4; ++m) { const int row = row0 + ai * HALF + m * 16; const float rs = row_rstd(ssq, row);
                f32x4 v[2][2]; float ss = 0.f;
#pragma unroll
                for (int bj = 0; bj < 2; ++bj)
#pragma unroll
                    for (int n = 0; n < 2; ++n) { v[bj][n] = acc[ai][bj][m][n] * rs; const f32x4 q = v[bj][n] * v[bj][n]; ss += (q[0] + q[1]) + (q[2] + q[3]); }
                if (t < 2) { ss += __shfl_xor(ss, 16); ss += __shfl_xor(ss, 32); const float hr = __builtin_amdgcn_rsqf(ss * (1.0f / 64.0f) + RMS_EPS);
#pragma unroll
                    for (int bj = 0; bj < 2; ++bj)
#pragma unroll
                        for (int n = 0; n < 2; ++n) v[bj][n] = v[bj][n] * g[bj][n] * hr; }
#pragma unroll
                for (int bj = 0; bj < 2; ++bj) *(u32x4*)(base + (size_t)row * 1024 + 32 * bj) = pack8(v[bj][0], v[bj][1]); }
    }
};
struct EpiSsdIn {
    static constexpr bool PERM = true, AFTER_DRAIN = false;
    bf16_t* zs; bf16_t* xbc; const float* ssq;
    __device__ __forceinline__ void operator()(const f32x4 (&acc)[2][2][4][2], const Unit& u, int wr, int wc, int fr, int fq) const {
        const int row0 = u.pm * BM + wr * 64 + fr;
#pragma unroll
        for (int ai = 0; ai < 2; ++ai)
#pragma unroll
            for (int m = 0; m < 4; ++m) { const int row = row0 + ai * HALF + m * 16; const float rs = row_rstd(ssq, row);
#pragma unroll
                for (int bj = 0; bj < 2; ++bj) { f32x4 v0 = acc[ai][bj][m][0] * rs, v1 = acc[ai][bj][m][1] * rs;
                    if (u.pn < 8) { v0 = silu4(v0); v1 = silu4(v1); *(u32x4*)(zs + (size_t)row * 2048 + 256 * u.pn + 128 * bj + 32 * wc + 8 * fq) = pack8(v0, v1); }
                    else *(u32x4*)(xbc + (size_t)row * 4096 + 256 * (u.pn - 8) + 128 * bj + 32 * wc + 8 * fq) = pack8(v0, v1); } }
    }
};
struct EpiGU {
    static constexpr bool PERM = true, AFTER_DRAIN = false;
    bf16_t* hb; const float* ssq;
    __device__ __forceinline__ void operator()(const f32x4 (&acc)[2][2][4][2], const Unit& u, int wr, int wc, int fr, int fq) const {
        const int row0 = u.pm * BM + wr * 64 + fr;
#pragma unroll
        for (int ai = 0; ai < 2; ++ai)
#pragma unroll
            for (int m = 0; m < 4; ++m) { const int row = row0 + ai * HALF + m * 16; const float rs = row_rstd(ssq, row);
                const f32x4 v0 = silu4(acc[ai][0][m][0] * rs) * (acc[ai][1][m][0] * rs), v1 = silu4(acc[ai][0][m][1] * rs) * (acc[ai][1][m][1] * rs);
                *(u32x4*)(hb + (size_t)row * 2816 + 128 * u.pn + 32 * wc + 8 * fq) = pack8(v0, v1); }
    }
};
struct EpiResid {
    static constexpr bool PERM = true, AFTER_DRAIN = false;
    float* x; bf16_t* xb; float* ssq;
    __device__ __forceinline__ void operator()(const f32x4 (&acc)[2][2][4][2], const Unit& u, int wr, int wc, int fr, int fq) const {
        const int row0 = u.pm * BM + wr * 64 + fr; const int col0 = u.pn * BM + 32 * wc + 8 * fq;
#pragma unroll
        for (int ai = 0; ai < 2; ++ai)
#pragma unroll
            for (int m = 0; m < 4; ++m) { const int row = row0 + ai * HALF + m * 16; float* xr = x + (size_t)row * 1024 + col0; float ss = 0.f;
#pragma unroll
                for (int bj = 0; bj < 2; ++bj) { f32x4 a = *(const f32x4*)(xr + 128 * bj), b = *(const f32x4*)(xr + 128 * bj + 4);
                    a = a + acc[ai][bj][m][0]; b = b + acc[ai][bj][m][1];
                    *(f32x4*)(xr + 128 * bj) = a; *(f32x4*)(xr + 128 * bj + 4) = b;
                    const f32x4 qa = a * a, qb = b * b; ss += ((qa[0] + qa[1]) + (qa[2] + qa[3])) + ((qb[0] + qb[1]) + (qb[2] + qb[3]));
                    *(u32x4*)(xb + (size_t)row * 1024 + col0 + 128 * bj) = pack8(a, b); }
                ss += __shfl_xor(ss, 16); ss += __shfl_xor(ss, 32);
                if (fq == 0) ssq[(size_t)row * 16 + 4 * u.pn + wc] = ss; }
    }
};


template <class Epi, class Sched, bool ALIGN_EPI = false, bool SP2 = false>
__device__ __forceinline__ void gemm_phase(PG8_LAS unsigned char* lds, const Gemm g, const Sched& S, const Epi& E) {
    const int tid = threadIdx.x, wid = __builtin_amdgcn_readfirstlane(tid >> 6), lane = tid & 63, wr = wid >> 2, wc = wid & 3, fr = lane & 15, fq = lane >> 4;
    const int K = g.K, nt = K / BK;
    unsigned voffA[2], voffB[2];
#pragma unroll
    for (int i = 0; i < 2; ++i) { int R, C; stage_rc(tid * 16 + i * 8192, R, C); const int Rb = Epi::PERM ? ((R & ~31) + perm32(R & 31)) : R;
        voffA[i] = (unsigned)(R * K + C) * 2u; voffB[i] = (unsigned)(Rb * K + C) * 2u; }
    const size_t kstep = (size_t)(BK * 2);
    const size_t hstep = (size_t)HALF * K * 2;
    const size_t tstep = 2 * hstep;
    const unsigned ldsw = (unsigned)wid * 1024u;
    const int aoff = lds_byte(wr * 64 + fr, fq * 8), boff = lds_byte(wc * 32 + fr, fq * 8);
#define PG8_SA(b, h) (((b) * 2 + (h)) * HTB)
#define PG8_SB(b, h) ((4 + (b) * 2 + (h)) * HTB)
#define PG8_STAGE(bufoff, gbase, voff) do { _Pragma("unroll") for (int _i = 0; _i < 2; ++_i) \
        __builtin_amdgcn_global_load_lds((const unsigned*)((const char*)(gbase) + (voff)[_i]), (PG8_LAS unsigned*)(lds + (bufoff) + ldsw + _i * 8192), 16, 0, 0); } while (0)
#define PG8_LDA(dst, b, h) do { _Pragma("unroll") for (int m = 0; m < 4; ++m) _Pragma("unroll") for (int k = 0; k < 2; ++k) dst[m][k] = *(const PG8_LAS bf16x8*)(lds + PG8_SA(b, h) + aoff + m * 2048 + k * 1024); } while (0)
#define PG8_LDB(dst, b, h) do { _Pragma("unroll") for (int n = 0; n < 2; ++n) _Pragma("unroll") for (int k = 0; k < 2; ++k) dst[n][k] = *(const PG8_LAS bf16x8*)(lds + PG8_SB(b, h) + boff + n * 2048 + k * 1024); } while (0)
#define PG8_MMA(ai, bj, At, Bt) do { __builtin_amdgcn_s_setprio(1); _Pragma("unroll") for (int m = 0; m < 4; ++m) _Pragma("unroll") for (int n = 0; n < 2; ++n) _Pragma("unroll") for (int k = 0; k < 2; ++k) \
        acc[ai][bj][m][n] = __builtin_amdgcn_mfma_f32_16x16x32_bf16(Bt[n][k], At[m][k], acc[ai][bj][m][n], 0, 0, 0); __builtin_amdgcn_s_setprio(0); } while (0)
#define PG8_WAIT_V(n) asm volatile("s_waitcnt vmcnt(" #n ")" ::: "memory")
#define PG8_WAIT_L(n) asm volatile("s_waitcnt lgkmcnt(" #n ")" ::: "memory")
#define PG8_BAR __builtin_amdgcn_s_barrier()
#define PG8_SCHED __builtin_amdgcn_sched_barrier(0)
    Unit cur, nxt; int ui = 0;
    if (!S.next(0, cur)) return;
    f32x4 acc[2][2][4][2];
#pragma unroll
    for (int a = 0; a < 2; ++a)
#pragma unroll
        for (int b = 0; b < 2; ++b)
#pragma unroll
            for (int m = 0; m < 4; ++m)
#pragma unroll
                for (int n = 0; n < 2; ++n) acc[a][b][m][n] = (f32x4){0.f, 0.f, 0.f, 0.f};
    bf16x8 At[4][2], B0[2][2], B1[2][2];
    const char* cA = (const char*)g.A + (size_t)cur.pm * tstep; const char* cB = (const char*)g.Bt + (size_t)cur.pn * tstep;
    S.a_ready(cur);
    if constexpr (SP2) {
        PG8_STAGE(PG8_SB(0, 0), cB, voffB); PG8_STAGE(PG8_SB(0, 1), cB + hstep, voffB); PG8_STAGE(PG8_SA(0, 0), cA, voffA); PG8_STAGE(PG8_SA(0, 1), cA + hstep, voffA);
        if (wr == 1) PG8_BAR;
        PG8_WAIT_V(2); PG8_BAR;
        PG8_STAGE(PG8_SB(1, 0), cB + kstep, voffB); PG8_STAGE(PG8_SA(1, 0), cA + kstep, voffA); PG8_STAGE(PG8_SB(1, 1), cB + hstep + kstep, voffB);
        PG8_WAIT_V(6); PG8_BAR;
    } else {
        PG8_STAGE(PG8_SB(0, 0), cB, voffB); PG8_STAGE(PG8_SA(0, 0), cA, voffA); PG8_STAGE(PG8_SB(0, 1), cB + hstep, voffB); PG8_STAGE(PG8_SA(0, 1), cA + hstep, voffA);
        if (wr == 1) PG8_BAR;
        PG8_WAIT_V(4); PG8_BAR;
        PG8_STAGE(PG8_SB(1, 0), cB + kstep, voffB); PG8_STAGE(PG8_SA(1, 0), cA + kstep, voffA); PG8_STAGE(PG8_SB(1, 1), cB + hstep + kstep, voffB);
        PG8_WAIT_V(6); PG8_BAR;
    }
    for (;;) {
        const bool has_next = S.next(ui + 1, nxt);
        const char* nA = has_next ? (const char*)g.A + (size_t)nxt.pm * tstep : cA; const char* nB = has_next ? (const char*)g.Bt + (size_t)nxt.pn * tstep : cB;
        for (int t = 0; t < nt; t += 2) {
            const bool last = (t == nt - 2);
            const char* a1 = cA + (size_t)(t + 1) * kstep;
            const char* a2 = last ? nA : cA + (size_t)(t + 2) * kstep; const char* b2 = last ? nB : cB + (size_t)(t + 2) * kstep;
            const char* a3 = a2 + kstep; const char* b3 = b2 + kstep;
            if (last && has_next) S.a_ready(nxt);
            if constexpr (SP2) {
            PG8_LDB(B0, 0, 0); PG8_LDB(B1, 0, 1); PG8_SCHED; PG8_LDA(At, 0, 0); PG8_STAGE(PG8_SA(1, 1), a1 + hstep, voffA);
            PG8_WAIT_V(8); PG8_WAIT_L(0); PG8_BAR; PG8_MMA(0, 0, At, B0); PG8_MMA(0, 1, At, B1); PG8_BAR; PG8_SCHED;
            PG8_LDA(At, 0, 1); PG8_STAGE(PG8_SB(0, 0), b2, voffB); PG8_STAGE(PG8_SB(0, 1), b2 + hstep, voffB); PG8_STAGE(PG8_SA(0, 0), a2, voffA);
            PG8_WAIT_V(8); PG8_WAIT_L(0); PG8_BAR; PG8_MMA(1, 0, At, B0); PG8_MMA(1, 1, At, B1); PG8_BAR; PG8_SCHED;
            PG8_LDB(B0, 1, 0); PG8_LDB(B1, 1, 1); PG8_SCHED; PG8_LDA(At, 1, 0); PG8_STAGE(PG8_SA(0, 1), a2 + hstep, voffA);
            PG8_WAIT_V(8); PG8_WAIT_L(0); PG8_BAR; PG8_MMA(0, 0, At, B0); PG8_MMA(0, 1, At, B1); PG8_BAR; PG8_SCHED;
            PG8_LDA(At, 1, 1); PG8_STAGE(PG8_SB(1, 0), b3, voffB); PG8_STAGE(PG8_SB(1, 1), b3 + hstep, voffB); PG8_STAGE(PG8_SA(1, 0), a3, voffA);
            PG8_WAIT_V(8); PG8_WAIT_L(0); PG8_BAR; PG8_MMA(1, 0, At, B0); PG8_MMA(1, 1, At, B1); PG8_BAR; PG8_SCHED;
            } else {
            PG8_LDB(B0, 0, 0); PG8_SCHED; PG8_LDA(At, 0, 0); PG8_STAGE(PG8_SA(1, 1), a1 + hstep, voffA);
            PG8_WAIT_L(8); PG8_BAR; PG8_WAIT_L(0); PG8_MMA(0, 0, At, B0); PG8_BAR; PG8_SCHED;
            PG8_LDB(B1, 0, 1); PG8_STAGE(PG8_SB(0, 0), b2, voffB);
            PG8_BAR; PG8_WAIT_L(0); PG8_MMA(0, 1, At, B1); PG8_BAR;
            PG8_LDA(At, 0, 1); PG8_STAGE(PG8_SA(0, 0), a2, voffA);
            PG8_BAR; PG8_WAIT_L(0); PG8_MMA(1, 0, At, B0); PG8_BAR; PG8_SCHED;
            PG8_STAGE(PG8_SB(0, 1), b2 + hstep, voffB);
            PG8_WAIT_V(6); PG8_BAR; PG8_MMA(1, 1, At, B1); PG8_BAR;
            PG8_LDB(B0, 1, 0); PG8_SCHED; PG8_LDA(At, 1, 0); PG8_STAGE(PG8_SA(0, 1), a2 + hstep, voffA);
            PG8_WAIT_L(8); PG8_BAR; PG8_WAIT_L(0); PG8_MMA(0, 0, At, B0); PG8_BAR; PG8_SCHED;
            PG8_LDB(B1, 1, 1); PG8_STAGE(PG8_SB(1, 0), b3, voffB);
            PG8_BAR; PG8_WAIT_L(0); PG8_MMA(0, 1, At, B1); PG8_BAR;
            PG8_LDA(At, 1, 1); PG8_STAGE(PG8_SA(1, 0), a3, voffA);
            PG8_BAR; PG8_WAIT_L(0); PG8_MMA(1, 0, At, B0); PG8_BAR; PG8_SCHED;
            PG8_STAGE(PG8_SB(1, 1), b3 + hstep, voffB);
            PG8_WAIT_V(6); PG8_BAR; PG8_MMA(1, 1, At, B1); PG8_BAR;
            }
        }
        if constexpr (ALIGN_EPI) { if (wr == 0) PG8_BAR; }
        if constexpr (!Epi::AFTER_DRAIN) { E(acc, cur, wr, wc, fr, fq); S.done(cur); }
        if (!has_next) break;
#pragma unroll
        for (int a = 0; a < 2; ++a)
#pragma unroll
            for (int b = 0; b < 2; ++b)
#pragma unroll
                for (int m = 0; m < 4; ++m)
#pragma unroll
                    for (int n = 0; n < 2; ++n) acc[a][b][m][n] = (f32x4){0.f, 0.f, 0.f, 0.f};
        cur = nxt; cA = nA; cB = nB; ++ui;
        if constexpr (ALIGN_EPI) { if (wr == 1) PG8_BAR; }
    }
    PG8_WAIT_V(0);
    if constexpr (!ALIGN_EPI) { if (wr == 0) PG8_BAR; }
    PG8_BAR;
    if constexpr (Epi::AFTER_DRAIN) { E.fused(acc, cur, wr, wc, fr, fq, lds, wid, lane); S.done(cur); }
#undef PG8_SA
#undef PG8_SB
#undef PG8_STAGE
#undef PG8_LDA
#undef PG8_LDB
#undef PG8_MMA
#undef PG8_WAIT_V
#undef PG8_WAIT_L
#undef PG8_BAR
#undef PG8_SCHED
}
}

namespace attn {
typedef unsigned short bf16_t;
using bf16x8 = __attribute__((ext_vector_type(8))) short;
using s16x4 = __attribute__((ext_vector_type(4))) short;
using f32x16 = __attribute__((ext_vector_type(16))) float;
using u32x4 = __attribute__((ext_vector_type(4))) unsigned;
constexpr int SEQ = 8192, DM = 1024, NW = 8, QBLK = 32, QB = 256, KVBLK = 64;
constexpr int SLOTB = 8192;
constexpr int LDS_K = 0, LDS_V = 2 * SLOTB, LDS_KX = 4 * SLOTB, LDS_WS = LDS_KX + 2 * 1024, LDS_OST = LDS_WS + NW * 256, LDS_BYTES = LDS_OST + NW * 4096;
__device__ __forceinline__ int crow(int r, int hi) { return (r & 3) + 8 * (r >> 2) + 4 * hi; }
#define SBAR() __builtin_amdgcn_sched_barrier(0)
__device__ __forceinline__ void cmask(f32x16& p0, f32x16& p1, int jb, int qrel, int hi) {
    const float NEG = -INFINITY; const int kb = 64 * jb + 4 * hi;
#pragma unroll
    for (int r = 0; r < 16; ++r) { const int kv = kb + (r & 3) + 8 * (r >> 2); if (kv > qrel) p0[r] = NEG; if (kv + 32 > qrel) p1[r] = NEG; }
}
__device__ __forceinline__ void glds16(const void* gsrc, unsigned lds_dst) { unsigned keep;
    asm volatile("s_mov_b32 %0, m0\n\ts_mov_b32 m0, %2\n\ts_nop 0\n\tglobal_load_lds_dwordx4 %1, off\n\ts_mov_b32 m0, %0" : "=&s"(keep) : "v"(gsrc), "s"(lds_dst) : "memory"); }
typedef float f32x2_t __attribute__((ext_vector_type(2))); typedef __bf16 bf16x2_t __attribute__((ext_vector_type(2)));
__device__ __forceinline__ unsigned cvtpk_s(float lo, float hi) { f32x2_t v = {lo, hi}; bf16x2_t b = __builtin_convertvector(v, bf16x2_t); return __builtin_bit_cast(unsigned, b); }
__device__ __forceinline__ void pv(f32x16* o, int vb, bf16x8 pa0, bf16x8 pa1, bf16x8 pa2, bf16x8 pa3) {
#pragma unroll
    for (int d0 = 0; d0 < 2; ++d0) { s16x4 lo[4], hi[4];
#pragma unroll
        for (int ks = 0; ks < 4; ++ks) {
            asm volatile("ds_read_b64_tr_b16 %0,%1 offset:%c2" : "=&v"(lo[ks]) : "v"(vb), "i"(d0 * 4096 + ks * 1024) : "memory");
            asm volatile("ds_read_b64_tr_b16 %0,%1 offset:%c2" : "=&v"(hi[ks]) : "v"(vb), "i"(d0 * 4096 + ks * 1024 + 512) : "memory"); }
        asm volatile("s_waitcnt lgkmcnt(0)" ::: "memory"); SBAR();
#define PK(k) (bf16x8){lo[k][0], lo[k][1], lo[k][2], lo[k][3], hi[k][0], hi[k][1], hi[k][2], hi[k][3]}
        o[d0] = __builtin_amdgcn_mfma_f32_32x32x16_bf16(pa0, PK(0), o[d0], 0, 0, 0);
        o[d0] = __builtin_amdgcn_mfma_f32_32x32x16_bf16(pa1, PK(1), o[d0], 0, 0, 0);
        o[d0] = __builtin_amdgcn_mfma_f32_32x32x16_bf16(pa2, PK(2), o[d0], 0, 0, 0);
        o[d0] = __builtin_amdgcn_mfma_f32_32x32x16_bf16(pa3, PK(3), o[d0], 0, 0, 0);
#undef PK
    }
}
__device__ __forceinline__ void attn_unit(int b, int h, int qb, int tfirst, const bf16_t* Q, const bf16_t* K, const bf16_t* V, bf16_t* O, const bf16_t* kx, const float* gt, char* shm) {
    const int tid = threadIdx.x, lane = tid & 63, r32 = lane & 31, hi = lane >> 5; const int wid = __builtin_amdgcn_readfirstlane(tid >> 6);
    const long rowbase = (long)b * SEQ; const int q0 = qb * QB; const int bh = b * 16 + h;
    const bf16_t* Qw = Q + (rowbase + q0 + wid * QBLK) * DM + h * 64;
    const bf16_t* Kh = K + rowbase * DM + h * 64; const bf16_t* Vh = V + rowbase * DM + h * 64;
    const bf16_t* kxh = kx + (size_t)bh * SEQ * 8; const float* gth = gt + bh * 128;
    const unsigned lds0 = (unsigned)(uintptr_t)shm;
    float* wsf = (float*)(shm + LDS_WS) + wid * 64;
    const bf16_t* ksrc = Kh + (long)lane * DM + wid * 8;
    const bf16_t* vsrc = Vh + (long)(16 * (wid & 3) + (lane >> 2)) * DM + (wid >> 2) * 32 + (lane & 3) * 8;
    const bf16_t* xsrc = kxh + (long)lane * 8;
    const unsigned kdst = lds0 + LDS_K + wid * 1024, vdst = lds0 + LDS_V + wid * 1024, xdst = lds0 + LDS_KX;
    const int vb0 = (int)(lds0 + LDS_V) + ((lane >> 4) & 1) * 32 + (lane & 3) * 8 + (4 * hi + ((lane & 15) >> 2)) * 64;
    const int NT = (q0 + QB) / KVBLK;
    bf16x8 qr[4];
#pragma unroll
    for (int d0 = 0; d0 < 4; ++d0) qr[d0] = *reinterpret_cast<const bf16x8*>(&Qw[(long)r32 * DM + d0 * 16 + hi * 8]);
    bf16x8 qx = (bf16x8){0, 0, 0, 0, 0, 0, 0, 0}; if (hi == 0) { qx[0] = (short)0x3F80; qx[1] = (short)0x3F80; qx[2] = (short)0x3F80; }
    float l_reg = 0.f; f32x16 o[2]; o[0] = f32x16{}; o[1] = f32x16{};
    const int qrel = wid * QBLK + r32;
#define DMA_TILE(t, s) do { glds16(ksrc + (long)(t) * KVBLK * DM, (unsigned)__builtin_amdgcn_readfirstlane(kdst + (s) * SLOTB)); \
        glds16(vsrc + (long)(t) * KVBLK * DM, (unsigned)__builtin_amdgcn_readfirstlane(vdst + (s) * SLOTB)); \
        if (wid == 0) glds16(xsrc + (long)(t) * KVBLK * 8, (unsigned)__builtin_amdgcn_readfirstlane(xdst + (s) * 1024)); } while (0)
    DMA_TILE(tfirst, 0);
    for (int t = tfirst; t < NT; ++t) {
        const int s = (t - tfirst) & 1;
        if (t + 1 < NT) { DMA_TILE(t + 1, s ^ 1);
            if (wid == 0) asm volatile("s_waitcnt vmcnt(3)" ::: "memory"); else asm volatile("s_waitcnt vmcnt(2)" ::: "memory"); }
        else asm volatile("s_waitcnt vmcnt(0)" ::: "memory");
        __builtin_amdgcn_s_barrier(); asm volatile("" ::: "memory");
        const float g = __hip_atomic_load(gth + t, __ATOMIC_RELAXED, __HIP_MEMORY_SCOPE_AGENT);
        f32x16 p0, p1;
        { const char* kb = shm + LDS_K + s * SLOTB + hi * 1024 + r32 * 16; const char* xb = shm + LDS_KX + s * 1024 + r32 * 16;
          const bf16x8 x0 = *reinterpret_cast<const bf16x8*>(xb), x1 = *reinterpret_cast<const bf16x8*>(xb + 512);
          p0 = __builtin_amdgcn_mfma_f32_32x32x16_bf16(x0, qx, f32x16{}, 0, 0, 0); p1 = __builtin_amdgcn_mfma_f32_32x32x16_bf16(x1, qx, f32x16{}, 0, 0, 0);
#pragma unroll
          for (int d0 = 0; d0 < 4; ++d0) { const bf16x8 b0 = *reinterpret_cast<const bf16x8*>(kb + d0 * 2048), b1 = *reinterpret_cast<const bf16x8*>(kb + d0 * 2048 + 512);
              p0 = __builtin_amdgcn_mfma_f32_32x32x16_bf16(b0, qr[d0], p0, 0, 0, 0); p1 = __builtin_amdgcn_mfma_f32_32x32x16_bf16(b1, qr[d0], p1, 0, 0, 0); } }
        { const int jb = t - (NT - 4); if (jb >= 0) cmask(p0, p1, jb, qrel, hi); }
        float sacc = 0.f;
#pragma unroll
        for (int r = 0; r < 16; ++r) { p0[r] = __builtin_amdgcn_exp2f(p0[r]); p1[r] = __builtin_amdgcn_exp2f(p1[r]); sacc += p0[r] + p1[r]; }
        l_reg = l_reg * g + sacc;
#pragma unroll
        for (int r = 0; r < 16; ++r) { o[0][r] *= g; o[1][r] *= g; }
        u32x4 pw0, pw1, pw2, pw3;
#define PKW(P, B) cvtpk_s(P[B], P[B + 1])
        pw0 = (u32x4){PKW(p0, 0), PKW(p0, 2), PKW(p0, 4), PKW(p0, 6)}; pw1 = (u32x4){PKW(p0, 8), PKW(p0, 10), PKW(p0, 12), PKW(p0, 14)};
        pw2 = (u32x4){PKW(p1, 0), PKW(p1, 2), PKW(p1, 4), PKW(p1, 6)}; pw3 = (u32x4){PKW(p1, 8), PKW(p1, 10), PKW(p1, 12), PKW(p1, 14)};
#undef PKW
        SBAR();
        pv(o, vb0 + s * SLOTB, __builtin_bit_cast(bf16x8, pw0), __builtin_bit_cast(bf16x8, pw1), __builtin_bit_cast(bf16x8, pw2), __builtin_bit_cast(bf16x8, pw3));
        asm volatile("s_waitcnt lgkmcnt(0)" ::: "memory"); __builtin_amdgcn_s_barrier(); asm volatile("" ::: "memory");
    }
#undef DMA_TILE
    { auto rr = __builtin_amdgcn_permlane32_swap(__float_as_uint(l_reg), __float_as_uint(l_reg), false, false); l_reg = __uint_as_float(rr[0]) + __uint_as_float(rr[1]); }
    if (hi == 0) wsf[32 + r32] = l_reg; asm volatile("s_waitcnt lgkmcnt(0)" ::: "memory");
    float rli[16];
#pragma unroll
    for (int r = 0; r < 16; ++r) rli[r] = __builtin_amdgcn_rcpf(wsf[32 + crow(r, hi)]);
    bf16_t* Ow = O + (rowbase + q0 + wid * QBLK) * DM + h * 64;
    { __hip_bfloat16* stg = (__hip_bfloat16*)(shm + LDS_OST) + wid * 2048;
#pragma unroll
      for (int r = 0; r < 16; ++r) { const int orow = crow(r, hi);
#pragma unroll
          for (int d0 = 0; d0 < 2; ++d0) stg[orow * 64 + d0 * 32 + r32] = __float2bfloat16(o[d0][r] * rli[r]); }
      asm volatile("s_waitcnt lgkmcnt(0)" ::: "memory");
#pragma unroll
      for (int i = 0; i < 4; ++i) { const int row = i * 8 + (lane >> 3), ch = lane & 7; const u32x4 v = *(const u32x4*)(stg + row * 64 + ch * 8); *(u32x4*)(Ow + (long)row * DM + ch * 8) = v; } }
    asm volatile("s_waitcnt lgkmcnt(0)\n\ts_barrier" ::: "memory");
}
#undef SBAR
}

namespace ssd {
typedef unsigned short bf16_t;
using bf16x8 = __attribute__((ext_vector_type(8))) short;
using s16x4 = __attribute__((ext_vector_type(4))) short;
using f32x16 = __attribute__((ext_vector_type(16))) float;
using f32x4 = __attribute__((ext_vector_type(4))) float;
using u32x4 = __attribute__((ext_vector_type(4))) unsigned;
using u32x2 = __attribute__((ext_vector_type(2))) unsigned;
constexpr int SEQ = 8192, L = 128, NCH = 64, XBC = 4096;
constexpr float LOG2E = 1.4426950408889634f;
typedef __attribute__((address_space(3))) unsigned char* lptr;
__device__ __forceinline__ int crow(int r, int hi) { return (r & 3) + 8 * (r >> 2) + 4 * hi; }
__device__ __forceinline__ float bf2f(unsigned short u) { return __uint_as_float((unsigned)u << 16); }
__device__ __forceinline__ unsigned cvtpk(float lo, float hi) { unsigned r; asm volatile("v_cvt_pk_bf16_f32 %0, %1, %2" : "=v"(r) : "v"(lo), "v"(hi)); return r; }
__device__ __forceinline__ float silu_f(float x) { return x * __builtin_amdgcn_rcpf(1.0f + __builtin_amdgcn_exp2f(-LOG2E * x)); }
__device__ __forceinline__ s16x4 vtr(lptr p) { typedef short v4i16_t __attribute__((ext_vector_type(4))); return __builtin_bit_cast(s16x4, __builtin_amdgcn_ds_read_tr16_b64_v4i16((__attribute__((address_space(3))) v4i16_t*)p)); }
#define SSD_BAR() do { asm volatile("s_waitcnt vmcnt(0) lgkmcnt(0)" ::: "memory"); __builtin_amdgcn_s_barrier(); asm volatile("" ::: "memory"); } while (0)

constexpr int IMG_X = 0;
constexpr int IMG_B = 65536;
constexpr int IMG_C = 98304;
constexpr int TAB = 131072;
constexpr int TAB_AC = TAB, TAB_DT = TAB + 2048, TAB_W = TAB + 4096, TAB_SS = TAB + 6144, TAB_NW = TAB + 8192, TAB_MISC = TAB + 9216;

__device__ __forceinline__ void conv8x8(const bf16_t* xb_batch, int t0, int ch, const float* cw, const float* cb, float (&out)[8][8]) {
    u32x4 raw[11];
#pragma unroll
    for (int i = 0; i < 11; ++i) { const int t = t0 - 3 + i; raw[i] = (t >= 0) ? *(const u32x4*)(xb_batch + (size_t)t * XBC + ch) : (u32x4){0u, 0u, 0u, 0u}; }
    f32x4 w[4][2], bias[2];
#pragma unroll
    for (int k = 0; k < 4; ++k) { w[k][0] = *(const f32x4*)(cw + k * XBC + ch); w[k][1] = *(const f32x4*)(cw + k * XBC + ch + 4); }
    bias[0] = *(const f32x4*)(cb + ch); bias[1] = *(const f32x4*)(cb + ch + 4);
#pragma unroll
    for (int r = 0; r < 8; ++r)
#pragma unroll
        for (int j = 0; j < 8; ++j) { float a = bias[j >> 2][j & 3];
#pragma unroll
            for (int k = 0; k < 4; ++k) { const unsigned wd = raw[r + k][j >> 1]; const float xv = (j & 1) ? __uint_as_float(wd & 0xffff0000u) : __uint_as_float(wd << 16); a += w[k][j >> 2][j & 3] * xv; }
            out[r][j] = silu_f(a); }
}
__device__ __forceinline__ void chunk_tables(lptr lds, const float* dt, const float* a_log, int row0, int g, int tid) {
    volatile __attribute__((address_space(3))) float* ac = (volatile __attribute__((address_space(3))) float*)(lds + TAB_AC);
    volatile __attribute__((address_space(3))) float* dtt = (volatile __attribute__((address_space(3))) float*)(lds + TAB_DT);
    volatile __attribute__((address_space(3))) float* misc = (volatile __attribute__((address_space(3))) float*)(lds + TAB_MISC);
    float v[4] = {0.f, 0.f, 0.f, 0.f};
    if (tid < 128) { const f32x4 d = *(const f32x4*)(dt + (size_t)(row0 + tid) * 32 + 4 * g);
#pragma unroll
        for (int k = 0; k < 4; ++k) { const float a = -__builtin_amdgcn_exp2f(LOG2E * a_log[4 * g + k]); dtt[k * 128 + tid] = d[k]; v[k] = d[k] * a * LOG2E; }
#pragma unroll
        for (int k = 0; k < 4; ++k) {
#pragma unroll
            for (int o = 1; o < 64; o <<= 1) { const float t = __shfl_up(v[k], o); if ((tid & 63) >= o) v[k] += t; }
            if (tid == 63) misc[k] = v[k]; }
    }
    SSD_BAR();
    if (tid < 128) {
#pragma unroll
        for (int k = 0; k < 4; ++k) { if (tid >= 64) v[k] += misc[k]; ac[k * 128 + tid] = v[k]; } }
    SSD_BAR();
}

__device__ __forceinline__ void s2_unit(lptr lds, int b, int c, int g, const bf16_t* xbc, const float* dt, const float* a_log, const float* cw, const float* cb, bf16_t* st_b, float* cdec) {
    const int tid = threadIdx.x, lane = tid & 63, r32 = lane & 31, hi = lane >> 5; const int wid = __builtin_amdgcn_readfirstlane(tid >> 6);
    const int row0 = b * SEQ + c * L; const bf16_t* xbat = xbc + (size_t)b * SEQ * XBC;
    chunk_tables(lds, dt, a_log, row0, g, tid);
    const __attribute__((address_space(3))) float* ac = (const __attribute__((address_space(3))) float*)(lds + TAB_AC);
    const __attribute__((address_space(3))) float* dtt = (const __attribute__((address_space(3))) float*)(lds + TAB_DT);
    if (tid < 4) cdec[(size_t)(b * NCH + c) * 32 + 4 * g + tid] = __builtin_amdgcn_exp2f(ac[tid * 128 + 127]);
    { const int cg = tid & 31, rg = tid >> 5; const int t0 = c * L + rg * 8; float out[8][8];
      conv8x8(xbat, t0, 256 * g + 8 * cg, cw, cb, out);
      const int k = cg >> 3;
#pragma unroll
      for (int r = 0; r < 8; ++r) { const int l = rg * 8 + r; const float w = __builtin_amdgcn_exp2f(ac[k * 128 + 127] - ac[k * 128 + l]) * dtt[k * 128 + l];
          u32x4 o; o.x = cvtpk(out[r][0] * w, out[r][1] * w); o.y = cvtpk(out[r][2] * w, out[r][3] * w); o.z = cvtpk(out[r][4] * w, out[r][5] * w); o.w = cvtpk(out[r][6] * w, out[r][7] * w);
          *(__attribute__((address_space(3))) u32x4*)(lds + IMG_X + (cg >> 2) * 8192 + l * 64 + (cg & 3) * 16) = o; } }
    if (tid < 256) { const int cg = tid & 15, rg = tid >> 4; const int t0 = c * L + rg * 8; float out[8][8];
      conv8x8(xbat, t0, 2048 + 128 * g + 8 * cg, cw, cb, out);
#pragma unroll
      for (int r = 0; r < 8; ++r) { const int l = rg * 8 + r;
          u32x4 o; o.x = cvtpk(out[r][0], out[r][1]); o.y = cvtpk(out[r][2], out[r][3]); o.z = cvtpk(out[r][4], out[r][5]); o.w = cvtpk(out[r][6], out[r][7]);
          *(__attribute__((address_space(3))) u32x4*)(lds + IMG_B + (cg >> 2) * 8192 + l * 64 + (cg & 3) * 16) = o; } }
    SSD_BAR();
    const int k = wid >> 1, nh = wid & 1;
    f32x16 acc[2][2];
#pragma unroll
    for (int i = 0; i < 2; ++i)
#pragma unroll
        for (int j = 0; j < 2; ++j) acc[i][j] = f32x16{};
    const int lanepat = (4 * hi + ((lane & 15) >> 2)) * 64 + ((lane >> 4) & 1) * 32 + (lane & 3) * 8;
#pragma unroll 2
    for (int ks = 0; ks < 8; ++ks) {
        bf16x8 af[2], bf[2];
#pragma unroll
        for (int i = 0; i < 2; ++i) { const lptr pa = lds + IMG_B + (2 * nh + i) * 8192 + ks * 1024 + lanepat; const s16x4 lo = vtr(pa), hh = vtr(pa + 512); af[i] = (bf16x8){lo[0], lo[1], lo[2], lo[3], hh[0], hh[1], hh[2], hh[3]};
                                      const lptr pb = lds + IMG_X + (2 * k + i) * 8192 + ks * 1024 + lanepat; const s16x4 lo2 = vtr(pb), hh2 = vtr(pb + 512); bf[i] = (bf16x8){lo2[0], lo2[1], lo2[2], lo2[3], hh2[0], hh2[1], hh2[2], hh2[3]}; }
#pragma unroll
        for (int i = 0; i < 2; ++i)
#pragma unroll
            for (int j = 0; j < 2; ++j) acc[i][j] = __builtin_amdgcn_mfma_f32_32x32x16_bf16(af[i], bf[j], acc[i][j], 0, 0, 0);
    }
    SSD_BAR();
#pragma unroll
    for (int i = 0; i < 2; ++i)
#pragma unroll
        for (int j = 0; j < 2; ++j)
#pragma unroll
            for (int rq = 0; rq < 4; ++rq) { const int p = 32 * j + r32, n = 64 * nh + 32 * i + 8 * rq + 4 * hi;
                u32x2 o; o.x = cvtpk(acc[i][j][4 * rq], acc[i][j][4 * rq + 1]); o.y = cvtpk(acc[i][j][4 * rq + 2], acc[i][j][4 * rq + 3]);
                *(__attribute__((address_space(3))) u32x2*)(lds + IMG_X + k * 16384 + p * 256 + n * 2) = o; }
    SSD_BAR();
    { bf16_t* dst = st_b + ((size_t)c * 32 + 4 * g) * 8192;
#pragma unroll
      for (int i = 0; i < 8; ++i) { const int off = (i * 512 + tid) * 16; *(u32x4*)((char*)dst + off) = *(const __attribute__((address_space(3))) u32x4*)(lds + IMG_X + off); } }
    SSD_BAR();
}

__device__ __forceinline__ void s3_scan(bf16_t* st0, bf16_t* st1, const float* cdec, int vcu, int G) {
    const int tid = threadIdx.x;
    for (int item = vcu; item < 256; item += G) {
        const int b = item >> 7, h = (item >> 2) & 31, qd = item & 3;
        bf16_t* base = (b == 0 ? st0 : st1) + (size_t)h * 8192 + qd * 2048 + tid * 4;
        const float* dc = cdec + (size_t)b * NCH * 32 + h;
        float hs[4] = {0.f, 0.f, 0.f, 0.f};
#pragma unroll 1
        for (int c0 = 0; c0 < NCH; c0 += 8) {
            u32x2 v[8]; float d[8];
#pragma unroll
            for (int i = 0; i < 8; ++i) { v[i] = *(const u32x2*)(base + (size_t)(c0 + i) * 32 * 8192); d[i] = __hip_atomic_load(dc + (c0 + i) * 32, __ATOMIC_RELAXED, __HIP_MEMORY_SCOPE_AGENT); }
#pragma unroll
            for (int i = 0; i < 8; ++i) { u32x2 o; o.x = cvtpk(hs[0], hs[1]); o.y = cvtpk(hs[2], hs[3]); *(u32x2*)(base + (size_t)(c0 + i) * 32 * 8192) = o;
                hs[0] = d[i] * hs[0] + __uint_as_float(v[i].x << 16); hs[1] = d[i] * hs[1] + __uint_as_float(v[i].x & 0xffff0000u);
                hs[2] = d[i] * hs[2] + __uint_as_float(v[i].y << 16); hs[3] = d[i] * hs[3] + __uint_as_float(v[i].y & 0xffff0000u); }
        }
    }
}

__device__ __forceinline__ void s4_unit(lptr lds, int b, int c, int g, const bf16_t* xbc, const float* dt, const float* a_log, const float* cw, const float* cb,
                                        const bf16_t* st_b, const float* dskip, const float* normw, bf16_t* zy) {
    const int tid = threadIdx.x, lane = tid & 63, r32 = lane & 31, hi = lane >> 5; const int wid = __builtin_amdgcn_readfirstlane(tid >> 6);
    const int row0 = b * SEQ + c * L; const bf16_t* xbat = xbc + (size_t)b * SEQ * XBC;
    chunk_tables(lds, dt, a_log, row0, g, tid);
    const __attribute__((address_space(3))) float* ac = (const __attribute__((address_space(3))) float*)(lds + TAB_AC);
    const __attribute__((address_space(3))) float* dtt = (const __attribute__((address_space(3))) float*)(lds + TAB_DT);
    __attribute__((address_space(3))) float* ssh = (__attribute__((address_space(3))) float*)(lds + TAB_SS);
    __attribute__((address_space(3))) float* nwt = (__attribute__((address_space(3))) float*)(lds + TAB_NW);
    if (tid < 256) nwt[tid] = normw[256 * g + tid];
    { const int cg = tid & 31, rg = tid >> 5; const int t0 = c * L + rg * 8; float out[8][8];
      conv8x8(xbat, t0, 256 * g + 8 * cg, cw, cb, out);
#pragma unroll
      for (int r = 0; r < 8; ++r) { const int l = rg * 8 + r;
          u32x4 o; o.x = cvtpk(out[r][0], out[r][1]); o.y = cvtpk(out[r][2], out[r][3]); o.z = cvtpk(out[r][4], out[r][5]); o.w = cvtpk(out[r][6], out[r][7]);
          *(__attribute__((address_space(3))) u32x4*)(lds + IMG_X + (cg >> 2) * 8192 + l * 64 + (cg & 3) * 16) = o; } }
    { const int half = tid >> 8, t2 = tid & 255; const int cg = t2 & 15, rg = t2 >> 4; const int t0 = c * L + rg * 8; float out[8][8];
      conv8x8(xbat, t0, 2048 + 1024 * half + 128 * g + 8 * cg, cw, cb, out);
#pragma unroll
      for (int r = 0; r < 8; ++r) { const int l = rg * 8 + r;
          u32x4 o; o.x = cvtpk(out[r][0], out[r][1]); o.y = cvtpk(out[r][2], out[r][3]); o.z = cvtpk(out[r][4], out[r][5]); o.w = cvtpk(out[r][6], out[r][7]);
          *(__attribute__((address_space(3))) u32x4*)(lds + (half ? IMG_C : IMG_B) + cg * 2048 + l * 16) = o; } }
    SSD_BAR();
    const int k = wid >> 1, lh = wid & 1, h = 4 * g + k;
    const int lanepat = (4 * hi + ((lane & 15) >> 2)) * 64 + ((lane >> 4) & 1) * 32 + (lane & 3) * 8;
    const bf16_t* prev = st_b + ((size_t)c * 32 + h) * 8192;
    f32x16 yT[2][2];
#pragma unroll
    for (int lt = 0; lt < 2; ++lt) {
        const int Lt = 2 * lh + lt; const int l = 32 * Lt + r32; const float acl = ac[k * 128 + l];
        yT[lt][0] = f32x16{}; yT[lt][1] = f32x16{};
        bf16x8 cf[8];
#pragma unroll
        for (int ks = 0; ks < 8; ++ks) cf[ks] = *(const __attribute__((address_space(3))) bf16x8*)(lds + IMG_C + (2 * ks + hi) * 2048 + l * 16);
        for (int st = 0; st <= Lt; ++st) {
            f32x16 cbt = f32x16{};
#pragma unroll
            for (int ks = 0; ks < 8; ++ks) { const bf16x8 bfr = *(const __attribute__((address_space(3))) bf16x8*)(lds + IMG_B + (2 * ks + hi) * 2048 + (32 * st + r32) * 16);
                cbt = __builtin_amdgcn_mfma_f32_32x32x16_bf16(bfr, cf[ks], cbt, 0, 0, 0); }
#pragma unroll
            for (int rq = 0; rq < 4; ++rq) { const int s0 = 32 * st + 8 * rq + 4 * hi;
                const f32x4 as = *(const __attribute__((address_space(3))) f32x4*)(ac + k * 128 + s0), ds = *(const __attribute__((address_space(3))) f32x4*)(dtt + k * 128 + s0);
#pragma unroll
                for (int j = 0; j < 4; ++j) { float w = cbt[4 * rq + j] * __builtin_amdgcn_exp2f(acl - as[j]) * ds[j]; if (s0 + j > l) w = 0.f; cbt[4 * rq + j] = w; } }
            bf16x8 wb[2];
#pragma unroll
            for (int sp = 0; sp < 2; ++sp) { u32x4 pk; pk.x = cvtpk(cbt[8 * sp], cbt[8 * sp + 1]); pk.y = cvtpk(cbt[8 * sp + 2], cbt[8 * sp + 3]); pk.z = cvtpk(cbt[8 * sp + 4], cbt[8 * sp + 5]); pk.w = cvtpk(cbt[8 * sp + 6], cbt[8 * sp + 7]); wb[sp] = __builtin_bit_cast(bf16x8, pk); }
#pragma unroll
            for (int pt = 0; pt < 2; ++pt)
#pragma unroll
                for (int sp = 0; sp < 2; ++sp) { const lptr pa = lds + IMG_X + (2 * k + pt) * 8192 + (32 * st + 16 * sp) * 64 + lanepat; const s16x4 lo = vtr(pa), hh = vtr(pa + 512);
                    const bf16x8 xf = (bf16x8){lo[0], lo[1], lo[2], lo[3], hh[0], hh[1], hh[2], hh[3]};
                    yT[lt][pt] = __builtin_amdgcn_mfma_f32_32x32x16_bf16(xf, wb[sp], yT[lt][pt], 0, 0, 0); }
        }
        const float eal = __builtin_amdgcn_exp2f(acl);
#pragma unroll
        for (int pt = 0; pt < 2; ++pt) { f32x16 t = f32x16{};
#pragma unroll
            for (int ks = 0; ks < 8; ++ks) { const bf16x8 pf = *(const bf16x8*)(prev + (size_t)(32 * pt + r32) * 128 + 16 * ks + 8 * hi);
                t = __builtin_amdgcn_mfma_f32_32x32x16_bf16(pf, cf[ks], t, 0, 0, 0); }
#pragma unroll
            for (int r = 0; r < 16; ++r) yT[lt][pt][r] += t[r] * eal; }
        const float dk = dskip[h];
#pragma unroll
        for (int pt = 0; pt < 2; ++pt)
#pragma unroll
            for (int rq = 0; rq < 4; ++rq) { const u32x2 xv = *(const __attribute__((address_space(3))) u32x2*)(lds + IMG_X + (2 * k + pt) * 8192 + l * 64 + (8 * rq + 4 * hi) * 2);
                yT[lt][pt][4 * rq] += dk * __uint_as_float(xv.x << 16); yT[lt][pt][4 * rq + 1] += dk * __uint_as_float(xv.x & 0xffff0000u);
                yT[lt][pt][4 * rq + 2] += dk * __uint_as_float(xv.y << 16); yT[lt][pt][4 * rq + 3] += dk * __uint_as_float(xv.y & 0xffff0000u); }
    }
    SSD_BAR();
    { const bf16_t* zsrc = zy + (size_t)row0 * 2048 + 256 * g;
#pragma unroll
      for (int i = 0; i < 8; ++i) { const int idx = i * 512 + tid; const int r = idx >> 5, ch = idx & 31;
          *(__attribute__((address_space(3))) u32x4*)(lds + IMG_B + r * 512 + ch * 16) = *(const u32x4*)(zsrc + (size_t)r * 2048 + ch * 8); } }
    SSD_BAR();
    float ssl[2];
#pragma unroll
    for (int lt = 0; lt < 2; ++lt) { const int l = 32 * (2 * lh + lt) + r32; float ss = 0.f;
#pragma unroll
        for (int pt = 0; pt < 2; ++pt)
#pragma unroll
            for (int rq = 0; rq < 4; ++rq) { const u32x2 zv = *(const __attribute__((address_space(3))) u32x2*)(lds + IMG_B + l * 512 + (64 * k + 32 * pt + 8 * rq + 4 * hi) * 2);
                float v0 = yT[lt][pt][4 * rq] * __uint_as_float(zv.x << 16), v1 = yT[lt][pt][4 * rq + 1] * __uint_as_float(zv.x & 0xffff0000u);
                float v2 = yT[lt][pt][4 * rq + 2] * __uint_as_float(zv.y << 16), v3 = yT[lt][pt][4 * rq + 3] * __uint_as_float(zv.y & 0xffff0000u);
                yT[lt][pt][4 * rq] = v0; yT[lt][pt][4 * rq + 1] = v1; yT[lt][pt][4 * rq + 2] = v2; yT[lt][pt][4 * rq + 3] = v3; ss += (v0 * v0 + v1 * v1) + (v2 * v2 + v3 * v3); }
        ss += __shfl_xor(ss, 32); ssl[lt] = ss;
        if (hi == 0) ssh[k * 128 + l] = ss; }
    SSD_BAR();
#pragma unroll
    for (int lt = 0; lt < 2; ++lt) { const int l = 32 * (2 * lh + lt) + r32;
        const float tot = (ssh[l] + ssh[128 + l]) + (ssh[256 + l] + ssh[384 + l]); const float rs = __builtin_amdgcn_rsqf(tot * (1.0f / 256.0f) + 1e-6f);
#pragma unroll
        for (int pt = 0; pt < 2; ++pt)
#pragma unroll
            for (int rq = 0; rq < 4; ++rq) { const int chn = 64 * k + 32 * pt + 8 * rq + 4 * hi; const f32x4 nw = *(const __attribute__((address_space(3))) f32x4*)(nwt + chn);
                u32x2 o; o.x = cvtpk(yT[lt][pt][4 * rq] * rs * nw[0], yT[lt][pt][4 * rq + 1] * rs * nw[1]); o.y = cvtpk(yT[lt][pt][4 * rq + 2] * rs * nw[2], yT[lt][pt][4 * rq + 3] * rs * nw[3]);
                *(__attribute__((address_space(3))) u32x2*)(lds + IMG_X + l * 512 + chn * 2) = o; } }
    SSD_BAR();
    { bf16_t* ydst = zy + (size_t)row0 * 2048 + 256 * g;
#pragma unroll
      for (int i = 0; i < 8; ++i) { const int idx = i * 512 + tid; const int r = idx >> 5, ch = idx & 31;
          *(u32x4*)(ydst + (size_t)r * 2048 + ch * 8) = *(const __attribute__((address_space(3))) u32x4*)(lds + IMG_X + r * 512 + ch * 16); } }
    SSD_BAR();
}
}

namespace misc {
typedef unsigned short bf16_t;
typedef float f32x4 __attribute__((ext_vector_type(4)));
typedef unsigned u32x4 __attribute__((ext_vector_type(4)));
typedef unsigned u32x2 __attribute__((ext_vector_type(2)));
typedef short bf16x8 __attribute__((ext_vector_type(8)));
typedef __attribute__((address_space(3))) unsigned char* lptr;
typedef __attribute__((address_space(3))) float* lfptr;
constexpr float LOG2E = 1.4426950408889634f;
__device__ __forceinline__ unsigned cvtpk(float lo, float hi) { unsigned r; asm volatile("v_cvt_pk_bf16_f32 %0, %1, %2" : "=v"(r) : "v"(lo), "v"(hi)); return r; }
#define MISC_BAR() do { asm volatile("s_waitcnt vmcnt(0) lgkmcnt(0)" ::: "memory"); __builtin_amdgcn_s_barrier(); asm volatile("" ::: "memory"); } while (0)

enum { MAP_ID = 0, MAP_CONV_IN = 1, MAP_FOX_IN = 2, MAP_GU = 3 };
template <int MAP> __device__ __forceinline__ int src_col32(int nb) {
    const int n = nb * 32;
    if (MAP == MAP_ID) return n;
    if (MAP == MAP_CONV_IN) { const int pn = n >> 8, t = n & 255; return pn < 8 ? ((t >> 7) ? 2048 : 1024) + 128 * pn + (t & 127) : 256 * (pn - 8) + t; }
    if (MAP == MAP_FOX_IN) { const int pn = n >> 8, t = n & 255; const int bj = t >> 7, wc = (t >> 5) & 3; return 256 * pn + 64 * wc + 32 * bj; }
      { const int pn = n >> 8, t = n & 255; return (t >> 7) * 2816 + 128 * pn + (t & 127); }
}
template <int MAP> __device__ __forceinline__ void transpose_item(const float* W, int K, int Nsrc, int Ndst, const float* nw, bf16_t* WT, lfptr scr, int item, int lane) {
    const int nblk = Ndst / 32, kb = item / nblk, nb = item % nblk, k0 = 64 * kb, n0 = 32 * nb, s0 = src_col32<MAP>(nb);
#pragma unroll 8
    for (int i = 0; i < 32; ++i) { const int kk = 2 * i + (lane >> 5); float v = W[(size_t)(k0 + kk) * Nsrc + s0 + (lane & 31)]; if (nw) v *= nw[k0 + kk]; scr[kk * 33 + (lane & 31)] = v; }
    asm volatile("s_waitcnt lgkmcnt(0)" ::: "memory");
    const int c = lane & 7;
#pragma unroll
    for (int j = 0; j < 4; ++j) { const int n = (lane >> 3) + 8 * j; const lfptr s = scr + (8 * c) * 33 + n;
        u32x4 o; o.x = cvtpk(s[0 * 33], s[1 * 33]); o.y = cvtpk(s[2 * 33], s[3 * 33]); o.z = cvtpk(s[4 * 33], s[5 * 33]); o.w = cvtpk(s[6 * 33], s[7 * 33]);
        *(u32x4*)(WT + (size_t)(n0 + n) * K + k0 + 8 * c) = o; }
    asm volatile("s_waitcnt lgkmcnt(0)" ::: "memory");
}
__device__ __forceinline__ void gate_cols(const float* W, int Nsrc, int c0, int ncol, const float* nw, bf16_t* WT, int gtid, int gthreads) {
    for (int idx = gtid; idx < ncol * 1024; idx += gthreads) { const int n = idx >> 10, k = idx & 1023; const float v = W[(size_t)k * Nsrc + c0 + n] * nw[k];
        WT[idx] = (bf16_t)(cvtpk(v, v) & 0xffffu); }
}
__device__ __forceinline__ void row_pass(const float* xrow, float* orow, bf16_t* xbrow, float* ssqrow, int lane) {
    const f32x4* xr = (const f32x4*)xrow + lane; f32x4 v[4]; float s = 0.f;
#pragma unroll
    for (int j = 0; j < 4; ++j) { v[j] = xr[64 * j]; s += (v[j][0] * v[j][0] + v[j][1] * v[j][1]) + (v[j][2] * v[j][2] + v[j][3] * v[j][3]); }
#pragma unroll
    for (int o = 1; o < 64; o <<= 1) s += __shfl_xor(s, o);
#pragma unroll
    for (int j = 0; j < 4; ++j) { ((f32x4*)orow + lane)[64 * j] = v[j]; u32x2 w; w.x = cvtpk(v[j][0], v[j][1]); w.y = cvtpk(v[j][2], v[j][3]); ((u32x2*)xbrow + lane)[64 * j] = w; }
    if (lane < 16) ssqrow[lane] = (lane == 0) ? s : 0.f;
}
__device__ __forceinline__ void conv_mix_item(const bf16_t* cv, const bf16_t* bb, const float* cw  , bf16_t* y, int item, int tid) {
    const int cg = tid & 127, rg = tid >> 7; const int row0 = item * 64 + rg * 16, ch = 8 * cg; const int t0 = row0 & 8191;
    float w[3][8];
#pragma unroll
    for (int k = 0; k < 3; ++k) { const f32x4 a = *(const f32x4*)(cw + k * 1024 + ch), b = *(const f32x4*)(cw + k * 1024 + ch + 4);
#pragma unroll
        for (int j = 0; j < 4; ++j) { w[k][j] = a[j]; w[k][4 + j] = b[j]; } }
    u32x4 c[18], g[16];
#pragma unroll
    for (int i = 0; i < 18; ++i) { const int t = t0 - 2 + i; c[i] = (t >= 0) ? *(const u32x4*)(cv + (size_t)(row0 - 2 + i) * 1024 + ch) : (u32x4){0u, 0u, 0u, 0u}; }
#pragma unroll
    for (int i = 0; i < 16; ++i) g[i] = *(const u32x4*)(bb + (size_t)(row0 + i) * 1024 + ch);
#pragma unroll
    for (int i = 0; i < 16; ++i) { float o[8];
#pragma unroll
        for (int j = 0; j < 8; ++j) { float a = 0.f;
#pragma unroll
            for (int k = 0; k < 3; ++k) { const unsigned wd = c[i + k][j >> 1]; const float xv = (j & 1) ? __uint_as_float(wd & 0xffff0000u) : __uint_as_float(wd << 16); a += w[k][j] * xv; }
            const unsigned gd = g[i][j >> 1]; const float gv = (j & 1) ? __uint_as_float(gd & 0xffff0000u) : __uint_as_float(gd << 16); o[j] = a * gv; }
        u32x4 ov; ov.x = cvtpk(o[0], o[1]); ov.y = cvtpk(o[2], o[3]); ov.z = cvtpk(o[4], o[5]); ov.w = cvtpk(o[6], o[7]);
        *(u32x4*)(y + (size_t)(row0 + i) * 1024 + ch) = ov; }
}
template <int NC> __device__ __forceinline__ void mini_gemm(lptr lds, const bf16_t* xb, const bf16_t* wg, const float* ssq, int row0, int tid) {
    const int lane = tid & 63, wid = tid >> 6, r16 = lane & 15, kg = lane >> 4;
    f32x4 acc[4][NC / 16];
#pragma unroll
    for (int rb = 0; rb < 4; ++rb)
#pragma unroll
        for (int nb = 0; nb < NC / 16; ++nb) acc[rb][nb] = (f32x4){0.f, 0.f, 0.f, 0.f};
#pragma unroll
    for (int ks = 0; ks < 4; ++ks) { const int k0 = 128 * wid + 32 * ks + 8 * kg;
        bf16x8 bfr[NC / 16];
#pragma unroll
        for (int nb = 0; nb < NC / 16; ++nb) bfr[nb] = *(const bf16x8*)(wg + (size_t)(16 * nb + r16) * 1024 + k0);
#pragma unroll
        for (int rb = 0; rb < 4; ++rb) { const bf16x8 afr = *(const bf16x8*)(xb + (size_t)(row0 + 16 * rb + r16) * 1024 + k0);
#pragma unroll
            for (int nb = 0; nb < NC / 16; ++nb) acc[rb][nb] = __builtin_amdgcn_mfma_f32_16x16x32_bf16(afr, bfr[nb], acc[rb][nb], 0, 0, 0); } }
    lfptr part = (lfptr)lds + wid * 64 * NC;
#pragma unroll
    for (int rb = 0; rb < 4; ++rb)
#pragma unroll
        for (int nb = 0; nb < NC / 16; ++nb)
#pragma unroll
            for (int j = 0; j < 4; ++j) part[(16 * rb + 4 * kg + j) * NC + 16 * nb + r16] = acc[rb][nb][j];
    MISC_BAR();
    lfptr red = (lfptr)lds + 8 * 64 * NC;
    for (int idx = tid; idx < 64 * NC; idx += 512) { float s = 0.f;
#pragma unroll
        for (int w = 0; w < 8; ++w) s += ((lfptr)lds)[w * 64 * NC + idx];
        const int row = row0 + idx / NC; const f32x4* p = (const f32x4*)(ssq + (size_t)row * 16); const f32x4 a = p[0], b = p[1], c = p[2], d = p[3];
        const float t = ((a[0] + a[1]) + (a[2] + a[3])) + ((b[0] + b[1]) + (b[2] + b[3])) + ((c[0] + c[1]) + (c[2] + c[3])) + ((d[0] + d[1]) + (d[2] + d[3]));
        red[idx] = s * __builtin_amdgcn_rsqf(t * (1.0f / 1024.0f) + 1e-6f); }
    MISC_BAR();
}
__device__ __forceinline__ void fox_gate_task(lptr lds, const bf16_t* xb, const bf16_t* wg, const float* ssq, const float* b_f, bf16_t* kx, float* gt, float* tl, int task, int tid) {
    const int row0 = task * 64; mini_gemm<16>(lds, xb, wg, ssq, row0, tid);
    const lfptr red = (lfptr)lds + 8 * 64 * 16; const int lane = tid & 63, wid = tid >> 6; const int b = row0 >> 13, tile = (row0 & 8191) >> 6;
#pragma unroll
    for (int hh = 0; hh < 2; ++hh) { const int h = 2 * wid + hh; const float xg = red[lane * 16 + h] + b_f[h];
        const float lf2 = -(fmaxf(-xg, 0.f) * LOG2E + __builtin_amdgcn_logf(1.0f + __builtin_amdgcn_exp2f(-fabsf(xg) * LOG2E)));
        float p = lf2;
#pragma unroll
        for (int o = 1; o < 64; o <<= 1) { const float t = __shfl_up(p, o); if (lane >= o) p += t; }
        const float tot = __shfl(p, 63); const float bias = tot - p;
        const unsigned h1 = cvtpk(bias, bias) & 0xffffu; const float r1 = bias - __uint_as_float(h1 << 16);
        const unsigned h2 = cvtpk(r1, r1) & 0xffffu; const float r2 = r1 - __uint_as_float(h2 << 16);
        const unsigned h3 = cvtpk(r2, r2) & 0xffffu;
        const int bh = b * 16 + h; u32x4 o; o.x = h1 | (h2 << 16); o.y = h3; o.z = 0u; o.w = 0u;
        *(u32x4*)(kx + ((size_t)bh * 8192 + (row0 & 8191) + lane) * 8) = o;
        if (lane == 0) { gt[bh * 128 + tile] = __builtin_amdgcn_exp2f(tot); tl[bh * 128 + tile] = tot; } }
    MISC_BAR();
}
__device__ __forceinline__ void ssd_dt_task(lptr lds, const bf16_t* xb, const bf16_t* wg, const float* ssq, const float* dt_bias, float* dt, int task, int tid) {
    const int row0 = task * 64; mini_gemm<32>(lds, xb, wg, ssq, row0, tid);
    const lfptr red = (lfptr)lds + 8 * 64 * 32;
    for (int idx = tid; idx < 64 * 32; idx += 512) { const float xg = red[idx] + dt_bias[idx & 31];
        const float sp = fmaxf(xg, 0.f) + 0.6931471805599453f * __builtin_amdgcn_logf(1.0f + __builtin_amdgcn_exp2f(-fabsf(xg) * LOG2E));
        dt[(size_t)row0 * 32 + idx] = sp; }
    MISC_BAR();
}
}

#define GAS __attribute__((address_space(1)))
#define LAS __attribute__((address_space(3)))
typedef unsigned short bf16;
typedef unsigned v4u __attribute__((ext_vector_type(4)));
typedef float f32x4 __attribute__((ext_vector_type(4)));
typedef short bf16x8 __attribute__((ext_vector_type(8)));
typedef GAS unsigned gu32;
typedef GAS unsigned long long gu64;
#define RLX_AGENT __ATOMIC_RELAXED, __HIP_MEMORY_SCOPE_AGENT
#define LDS_WAIT() asm volatile("s_waitcnt lgkmcnt(0)" ::: "memory")
#define VM_WAIT() asm volatile("s_waitcnt vmcnt(0)" ::: "memory")
__device__ __forceinline__ unsigned long long rt() { return __builtin_amdgcn_s_memrealtime(); }
__device__ __forceinline__ unsigned f2bf(float f) { unsigned u = __builtin_bit_cast(unsigned, f); return (u + 0x7fffu + ((u >> 16) & 1u)) >> 16; }
__device__ __forceinline__ unsigned pk2(float lo, float hi) { return f2bf(lo) | (f2bf(hi) << 16); }

#define XB_TMO      128
#define XB_XCNT(j)  (256  + 64 * (j))
#define XB_XSUB(j)  (1280 + 64 * (j))
#define XB_XGEN(j)  (2304 + 64 * (j))
#define XB_TOP      3328
#define XB_TOPGEN   3392
#define XCD_BAR_WORDS 3456
#define XB_SPIN_CAP (1u << 18)

__device__ __forceinline__ unsigned xb_ld(unsigned* p)              { return __hip_atomic_load(p, __ATOMIC_RELAXED, __HIP_MEMORY_SCOPE_AGENT); }
__device__ __forceinline__ unsigned xb_add(unsigned* p, unsigned v) { return __hip_atomic_fetch_add(p, v, __ATOMIC_RELAXED, __HIP_MEMORY_SCOPE_AGENT); }
__device__ __forceinline__ unsigned xb_xcc_id() { return (unsigned)__builtin_amdgcn_s_getreg((3 << 11) | 20) & 0xFu; }
#define XB_SPIN(cond, bar) do { unsigned _sp = 0; while (cond) { __builtin_amdgcn_s_sleep(1); \
    if ((++_sp & 255u) == 0u) { if (xb_ld(&(bar)[XB_TMO])) break; if (_sp > XB_SPIN_CAP) { atomicAdd(&(bar)[XB_TMO], 1u); break; } } } } while (0)

struct XcdBarrier {
    unsigned* bar; unsigned x;
    volatile LAS unsigned* st;
};

__device__ __forceinline__ XcdBarrier xcd_barrier_post(unsigned* bar, volatile LAS unsigned* st) {
    XcdBarrier b; b.bar = bar; b.x = xb_xcc_id(); b.st = st;
    if (threadIdx.x == 0) (void)xb_add(&bar[XB_XCNT(b.x)], 1u);
    return b;
}
__device__ __forceinline__ void xcd_barrier_complete(unsigned* bar, unsigned x, unsigned& nloc, unsigned& nx) {
    const unsigned G = gridDim.x * gridDim.y * gridDim.z;
    unsigned sum, cnt, mine, sp = 0u;
    for (;;) {
        sum = 0u; cnt = 0u; mine = 0u;
#pragma unroll
        for (unsigned j = 0; j < 16; ++j) { const unsigned c = xb_ld(&bar[XB_XCNT(j)]); sum += c; cnt += (c > 0u) ? 1u : 0u; mine = (j == x) ? c : mine; }
        if (sum == G) break;
        __builtin_amdgcn_s_sleep(1);
        if ((++sp & 255u) == 0u) { if (xb_ld(&bar[XB_TMO])) break; if (sp > XB_SPIN_CAP) { atomicAdd(&bar[XB_TMO], 1u); break; } }
    }
    nloc = mine > 0u ? mine : 1u; nx = cnt > 0u ? cnt : 1u;
}

__device__ __forceinline__ void xcd_barrier(const XcdBarrier& b) {
    asm volatile("s_waitcnt vmcnt(0)" ::: "memory");
    __syncthreads();
    if (threadIdx.x == 0) {
        unsigned* bar = b.bar;
        __builtin_amdgcn_s_waitcnt(0);
        unsigned nloc = b.st[0], nx = b.st[1];
        if (nloc == 0u) { xcd_barrier_complete(bar, b.x, nloc, nx); b.st[0] = nloc; b.st[1] = nx; }
        const unsigned old = xb_add(&bar[XB_XSUB(b.x)], 1u);
        const unsigned gen = old / nloc;
        if (old + 1u == (gen + 1u) * nloc) {
            __builtin_amdgcn_fence(__ATOMIC_RELEASE, "agent");
            asm volatile("s_waitcnt vmcnt(0)" ::: "memory");
            const unsigned og = xb_add(&bar[XB_TOP], 1u);
            const unsigned tg = og / nx;
            if (og + 1u == (tg + 1u) * nx) xb_add(&bar[XB_TOPGEN], 1u);
            else XB_SPIN(xb_ld(&bar[XB_TOPGEN]) == tg, bar);
            __builtin_amdgcn_fence(__ATOMIC_ACQUIRE, "agent");
            xb_add(&bar[XB_XGEN(b.x)], 1u);
            asm volatile("s_waitcnt vmcnt(0)" ::: "memory");
        } else {
            XB_SPIN(xb_ld(&bar[XB_XGEN(b.x)]) == gen, bar);
            __builtin_amdgcn_fence(__ATOMIC_ACQUIRE, "agent");
            asm volatile("s_waitcnt vmcnt(0)" ::: "memory");
        }
    }
    __syncthreads();
}

constexpr int NWAVES = 8;
#ifndef MK_N_LAUNCHES
#define MK_N_LAUNCHES 0
#endif
constexpr int M = 16384, DMODEL = 1024, FF = 2816, NGU = 5632, SEQ = 8192;
constexpr size_t MiB = 1u << 20;
constexpr size_t WS_CTL = 0, CTL_ZERO_BYTES = 64 * 1024;
constexpr size_t WS_W = 1 * MiB;
constexpr size_t SZ_CIN = (size_t)3072 * 1024 * 2, SZ_SQ = (size_t)1024 * 1024 * 2, SZ_GU = (size_t)NGU * 1024 * 2, SZ_DN = (size_t)1024 * FF * 2, SZ_SIN = (size_t)6144 * 1024 * 2, SZ_SOUT = (size_t)1024 * 2048 * 2;
constexpr size_t W_L0_IN = WS_W, W_L0_OUT = W_L0_IN + SZ_CIN, W_L0_GU = W_L0_OUT + SZ_SQ, W_L0_DN = W_L0_GU + SZ_GU;
constexpr size_t W_L1_IN = W_L0_DN + SZ_DN, W_L1_OUT = W_L1_IN + SZ_CIN, W_L1_GU = W_L1_OUT + SZ_SQ, W_L1_DN = W_L1_GU + SZ_GU;
constexpr size_t W_L2_IN = W_L1_DN + SZ_DN, W_L2_OUT = W_L2_IN + SZ_SIN, W_L2_GU = W_L2_OUT + SZ_SOUT, W_L2_DN = W_L2_GU + SZ_GU;
constexpr size_t W_L3_IN = W_L2_DN + SZ_DN, W_L3_OUT = W_L3_IN + SZ_CIN, W_L3_GU = W_L3_OUT + SZ_SQ, W_L3_DN = W_L3_GU + SZ_GU;
constexpr size_t W_END = W_L3_DN + SZ_DN;
static_assert(W_END <= 107 * MiB, "weights");
constexpr size_t WS_WGATE = 107 * MiB;
constexpr size_t WS_XB = 108 * MiB;
constexpr size_t WS_SSQ = 140 * MiB;
constexpr size_t WS_KX = 141 * MiB;
constexpr size_t WS_DT = 145 * MiB;
constexpr size_t WS_GT = 147 * MiB;
constexpr size_t WS_T = 148 * MiB;
constexpr size_t WS_H = WS_T;
constexpr size_t WS_CV = WS_T, WS_BB = WS_T + 32 * MiB, WS_Y = WS_T + 64 * MiB;
constexpr size_t WS_Q = WS_T;
constexpr size_t WS_ZY = WS_T, WS_XBC = WS_T + 64 * MiB;
constexpr size_t WS_ST0 = WS_XB, WS_ST1 = WS_W;
constexpr size_t WS_END = WS_XBC + 128 * MiB;
static_assert(WS_ST1 + 32 * MiB <= W_L2_IN, "states of batch 1 must only cover dead weights");
static_assert(WS_END == 340 * MiB, "ws map");
constexpr int CW_FLAG = 16;
constexpr int CW_BAR = 1024;
constexpr int RING_OFF = 0, RING_BYTES = 131072;
constexpr int LDSCTL_OFF = 146432, MISC_OFF = LDSCTL_OFF + 320;
constexpr int LDS_BYTES = 147456;
static_assert(attn::LDS_BYTES <= RING_BYTES && ssd::TAB_MISC + 64 <= LDSCTL_OFF, "LDS map");

struct Args { const float* in[21]; float* out; unsigned char* ws; int ph_lo, ph_hi; };
enum { PH_PRO = 0, PH_L0_IN, PH_L0_MIX, PH_L0_OUT, PH_L0_GU, PH_L0_DN,
       PH_L1_IN, PH_L1_ATT, PH_L1_OUT, PH_L1_GU, PH_L1_DN,
       PH_L2_IN, PH_L2_S2, PH_L2_S3, PH_L2_S4, PH_L2_OUT, PH_L2_GU, PH_L2_DN,
       PH_L3_IN, PH_L3_MIX, PH_L3_OUT, PH_L3_GU, PH_L3_DN, PH_COUNT };

__global__ void __launch_bounds__(NWAVES * 64, 2) mega_fwd(Args args) {
    extern __shared__ __attribute__((aligned(16))) unsigned char lds[];
    LAS unsigned char* const L = (LAS unsigned char*)lds;
    const int tid = threadIdx.x, lane = tid & 63, wave = __builtin_amdgcn_readfirstlane(tid >> 6);
    const int G = gridDim.x; const int bx = blockIdx.x; const int vcu = (G % 8 == 0) ? (bx % 8) * (G / 8) + bx / 8 : bx;
    unsigned char* const ws = args.ws;
    gu32* const ctl = (gu32*)(ws + WS_CTL);
    for (int u = tid; u < (LDS_BYTES - LDSCTL_OFF) / 4; u += NWAVES * 64) ((LAS unsigned*)(L + LDSCTL_OFF))[u] = 0u;
    __syncthreads();
    XcdBarrier bar; bar.bar = (unsigned*)(ctl + CW_BAR); bar.x = 0; bar.st = nullptr;
    if (MK_N_LAUNCHES == 1) bar = xcd_barrier_post((unsigned*)(ctl + CW_BAR), (volatile LAS unsigned*)(L + MISC_OFF) + 8);
    const int lo = args.ph_lo, hi = args.ph_hi;
#define IN(k) (lo <= (k) && (k) < hi)
#define SEAM(k) do { if (IN(k) && IN((k) + 1)) xcd_barrier(bar); } while (0)
    typedef pg8::bf16_t bf16_t;
    float* const X = args.out;
    bf16_t* const XB = (bf16_t*)(ws + WS_XB); float* const SSQ = (float*)(ws + WS_SSQ);
    const float* const mix_norm = args.in[1]; const float* const ffn_norm = args.in[2];

    if (IN(PH_PRO)) {
        misc::lfptr scr = (misc::lfptr)(L + RING_OFF + wave * 16384);
        const int gw = vcu * NWAVES + wave, NGW = G * NWAVES;
#define RUN_JOB(Wp, K_, NS_, ND_, MAP_, NWp, DST_) do { const int nitems = ((K_) / 64) * ((ND_) / 32); \
            for (int it = gw; it < nitems; it += NGW) misc::transpose_item<MAP_>((Wp), (K_), (NS_), (ND_), (NWp), (bf16_t*)(ws + (DST_)), scr, it, lane); } while (0)
        for (int i = 0; i < 4; ++i) {
            const size_t gu_dst = (i == 0 ? W_L0_GU : i == 1 ? W_L1_GU : i == 2 ? W_L2_GU : W_L3_GU), dn_dst = (i == 0 ? W_L0_DN : i == 1 ? W_L1_DN : i == 2 ? W_L2_DN : W_L3_DN);
            RUN_JOB(args.in[3] + (size_t)i * 1024 * NGU, 1024, NGU, NGU, misc::MAP_GU, ffn_norm + i * 1024, gu_dst);
            RUN_JOB(args.in[4] + (size_t)i * FF * 1024, FF, 1024, 1024, misc::MAP_ID, (const float*)nullptr, dn_dst);
        }
        for (int j = 0; j < 2; ++j) {
            RUN_JOB(args.in[5] + (size_t)j * 1024 * 3072, 1024, 3072, 3072, misc::MAP_CONV_IN, mix_norm + (j == 0 ? 0 : 3) * 1024, (j == 0 ? W_L0_IN : W_L3_IN));
            RUN_JOB(args.in[7] + (size_t)j * 1024 * 1024, 1024, 1024, 1024, misc::MAP_ID, (const float*)nullptr, (j == 0 ? W_L0_OUT : W_L3_OUT));
        }
        RUN_JOB(args.in[8], 1024, 3088, 3072, misc::MAP_FOX_IN, mix_norm + 1024, W_L1_IN);
        RUN_JOB(args.in[12], 1024, 1024, 1024, misc::MAP_ID, (const float*)nullptr, W_L1_OUT);
        RUN_JOB(args.in[13], 1024, 6176, 6144, misc::MAP_ID, mix_norm + 2048, W_L2_IN);
        RUN_JOB(args.in[20], 2048, 1024, 1024, misc::MAP_ID, (const float*)nullptr, W_L2_OUT);
#undef RUN_JOB
        misc::gate_cols(args.in[8], 3088, 3072, 16, mix_norm + 1024, (bf16_t*)(ws + WS_WGATE), vcu * 512 + tid, G * 512);
        misc::gate_cols(args.in[13], 6176, 6144, 32, mix_norm + 2048, (bf16_t*)(ws + WS_WGATE + 65536), vcu * 512 + tid, G * 512);
        for (int m = gw; m < M; m += NGW) misc::row_pass(args.in[0] + (size_t)m * 1024, X + (size_t)m * 1024, XB + (size_t)m * 1024, SSQ + (size_t)m * 16, lane);
        asm volatile("s_waitcnt vmcnt(0) lgkmcnt(0)" ::: "memory"); __syncthreads();
    }
    SEAM(PH_PRO);

#define FFN_PHASES(PH_GU_, PH_DN_, WGU_, WDN_) do { \
    if (IN(PH_GU_)) { pg8::Gemm g{XB, (const bf16_t*)(ws + (WGU_)), M, NGU, 1024}; pg8::StaticOrder S; S.init(M, NGU, G, bx); \
        pg8::EpiGU E{(bf16_t*)(ws + WS_H), SSQ}; pg8::gemm_phase<pg8::EpiGU, pg8::StaticOrder, true, true>(L + RING_OFF, g, S, E); } \
    SEAM(PH_GU_); \
    if (IN(PH_DN_)) { pg8::Gemm g{(const bf16_t*)(ws + WS_H), (const bf16_t*)(ws + (WDN_)), M, 1024, FF}; pg8::StaticOrder S; S.init(M, 1024, G, bx); \
        pg8::EpiResid E{X, XB, SSQ}; pg8::gemm_phase<pg8::EpiResid, pg8::StaticOrder, true, true>(L + RING_OFF, g, S, E); } \
    SEAM(PH_DN_); } while (0)
#define CONV_LAYER(PH_IN_, PH_MIX_, PH_OUT_, WIN_, WOUT_, J_) do { \
    if (IN(PH_IN_)) { pg8::Gemm g{XB, (const bf16_t*)(ws + (WIN_)), M, 3072, 1024}; pg8::StaticOrder S; S.init(M, 3072, G, bx); \
        pg8::EpiConvIn E{(bf16_t*)(ws + WS_CV), (bf16_t*)(ws + WS_BB), SSQ}; pg8::gemm_phase<pg8::EpiConvIn, pg8::StaticOrder, true, true>(L + RING_OFF, g, S, E); } \
    SEAM(PH_IN_); \
    if (IN(PH_MIX_)) { for (int it = vcu; it < M / 64; it += G) misc::conv_mix_item((const bf16_t*)(ws + WS_CV), (const bf16_t*)(ws + WS_BB), args.in[6] + (J_) * 3 * 1024, (bf16_t*)(ws + WS_Y), it, tid); \
        asm volatile("s_waitcnt vmcnt(0)" ::: "memory"); __syncthreads(); } \
    SEAM(PH_MIX_); \
    if (IN(PH_OUT_)) { pg8::Gemm g{(const bf16_t*)(ws + WS_Y), (const bf16_t*)(ws + (WOUT_)), M, 1024, 1024}; pg8::StaticOrder S; S.init(M, 1024, G, bx); \
        pg8::EpiResid E{X, XB, SSQ}; pg8::gemm_phase<pg8::EpiResid, pg8::StaticOrder, true, true>(L + RING_OFF, g, S, E); } \
    SEAM(PH_OUT_); } while (0)

    CONV_LAYER(PH_L0_IN, PH_L0_MIX, PH_L0_OUT, W_L0_IN, W_L0_OUT, 0);
    FFN_PHASES(PH_L0_GU, PH_L0_DN, W_L0_GU, W_L0_DN);

    if (IN(PH_L1_IN)) {
        pg8::Gemm g{XB, (const bf16_t*)(ws + W_L1_IN), M, 3072, 1024}; pg8::StaticOrder S; S.init(M, 3072, G, bx);
        pg8::EpiFoxIn E{(bf16_t*)(ws + WS_Q), SSQ, args.in[10], args.in[11], 0.125f * 1.4426950408889634f};
        pg8::gemm_phase<pg8::EpiFoxIn, pg8::StaticOrder, true, true>(L + RING_OFF, g, S, E);
        for (int task = vcu; task < M / 64; task += G)
            misc::fox_gate_task((misc::lptr)(L + RING_OFF), XB, (const bf16_t*)(ws + WS_WGATE), SSQ, args.in[9], (bf16_t*)(ws + WS_KX), (float*)(ws + WS_GT), (float*)(ws + WS_GT + 65536), task, tid);
    }
    SEAM(PH_L1_IN);
    if (IN(PH_L1_ATT)) {
        if (G == 256) {
            const int s8 = vcu & 7, bh = vcu >> 3;
            for (int i = 0; i < 4; ++i) { const int qb = (i == 0) ? s8 : (i == 1) ? 15 - s8 : (i == 2) ? 16 + s8 : 31 - s8;
                attn::attn_unit(bh >> 4, bh & 15, qb, 0, (const bf16_t*)(ws + WS_Q), (const bf16_t*)(ws + WS_Q + 32 * MiB), (const bf16_t*)(ws + WS_Q + 64 * MiB), (bf16_t*)(ws + WS_Q),
                                (const bf16_t*)(ws + WS_KX), (const float*)(ws + WS_GT), (char*)lds + RING_OFF); }
        } else {
            for (int u = vcu; u < 1024; u += G) attn::attn_unit(u >> 9, (u >> 5) & 15, u & 31, 0, (const bf16_t*)(ws + WS_Q), (const bf16_t*)(ws + WS_Q + 32 * MiB), (const bf16_t*)(ws + WS_Q + 64 * MiB), (bf16_t*)(ws + WS_Q),
                                (const bf16_t*)(ws + WS_KX), (const float*)(ws + WS_GT), (char*)lds + RING_OFF);
        }
        asm volatile("s_waitcnt vmcnt(0)" ::: "memory"); __syncthreads();
    }
    SEAM(PH_L1_ATT);
    if (IN(PH_L1_OUT)) { pg8::Gemm g{(const bf16_t*)(ws + WS_Q), (const bf16_t*)(ws + W_L1_OUT), M, 1024, 1024}; pg8::StaticOrder S; S.init(M, 1024, G, bx);
        pg8::EpiResid E{X, XB, SSQ}; pg8::gemm_phase<pg8::EpiResid, pg8::StaticOrder, true, true>(L + RING_OFF, g, S, E); }
    SEAM(PH_L1_OUT);
    FFN_PHASES(PH_L1_GU, PH_L1_DN, W_L1_GU, W_L1_DN);

    if (IN(PH_L2_IN)) {
        pg8::Gemm g{XB, (const bf16_t*)(ws + W_L2_IN), M, 6144, 1024}; pg8::StaticOrder S; S.init(M, 6144, G, bx);
        pg8::EpiSsdIn E{(bf16_t*)(ws + WS_ZY), (bf16_t*)(ws + WS_XBC), SSQ};
        pg8::gemm_phase<pg8::EpiSsdIn, pg8::StaticOrder, true, true>(L + RING_OFF, g, S, E);
        for (int task = vcu; task < M / 64; task += G)
            misc::ssd_dt_task((misc::lptr)(L + RING_OFF), XB, (const bf16_t*)(ws + WS_WGATE + 65536), SSQ, args.in[16], (float*)(ws + WS_DT), task, tid);
    }
    SEAM(PH_L2_IN);
    if (IN(PH_L2_S2)) {
        for (int u = vcu; u < 1024; u += G) { const int b = u >> 9, c = (u >> 3) & 63, g = u & 7;
            ssd::s2_unit((ssd::lptr)(L + RING_OFF), b, c, g, (const bf16_t*)(ws + WS_XBC), (const float*)(ws + WS_DT), args.in[17], args.in[14], args.in[15],
                         (bf16_t*)(ws + (b == 0 ? WS_ST0 : WS_ST1)), (float*)(ws + WS_GT + 131072)); }
    }
    SEAM(PH_L2_S2);
    if (IN(PH_L2_S3)) { ssd::s3_scan((bf16_t*)(ws + WS_ST0), (bf16_t*)(ws + WS_ST1), (const float*)(ws + WS_GT + 131072), vcu, G); asm volatile("s_waitcnt vmcnt(0)" ::: "memory"); __syncthreads(); }
    SEAM(PH_L2_S3);
    if (IN(PH_L2_S4)) {
        for (int u = vcu; u < 1024; u += G) { const int b = u >> 9, c = (u >> 3) & 63, g = u & 7;
            ssd::s4_unit((ssd::lptr)(L + RING_OFF), b, c, g, (const bf16_t*)(ws + WS_XBC), (const float*)(ws + WS_DT), args.in[17], args.in[14], args.in[15],
                         (const bf16_t*)(ws + (b == 0 ? WS_ST0 : WS_ST1)), args.in[18], args.in[19], (bf16_t*)(ws + WS_ZY)); }
    }
    SEAM(PH_L2_S4);
    if (IN(PH_L2_OUT)) { pg8::Gemm g{(const bf16_t*)(ws + WS_ZY), (const bf16_t*)(ws + W_L2_OUT), M, 1024, 2048}; pg8::StaticOrder S; S.init(M, 1024, G, bx);
        pg8::EpiResid E{X, XB, SSQ}; pg8::gemm_phase<pg8::EpiResid, pg8::StaticOrder, true, true>(L + RING_OFF, g, S, E); }
    SEAM(PH_L2_OUT);
    FFN_PHASES(PH_L2_GU, PH_L2_DN, W_L2_GU, W_L2_DN);

    CONV_LAYER(PH_L3_IN, PH_L3_MIX, PH_L3_OUT, W_L3_IN, W_L3_OUT, 1);
    FFN_PHASES(PH_L3_GU, PH_L3_DN, W_L3_GU, W_L3_DN);
#undef IN
#undef SEAM
}

extern "C" void kernel_launch(void* const* d_in, const int* in_sizes, int n_in, void* d_out, int out_size, void* d_ws, size_t ws_size, hipStream_t stream) {
    static int grid = 0;
    if (grid == 0) {
        if (n_in != 21 || in_sizes[0] != M * DMODEL || out_size != M * DMODEL || ws_size < WS_END) {
            fprintf(stderr, "kernel_launch: unexpected shapes (n_in %d, in0 %d, out %d, ws %zu < %zu); nothing launched\n", n_in, n_in > 0 ? in_sizes[0] : -1, out_size, ws_size, (size_t)WS_END); grid = -1; return; }
        int dev = 0, cus = 0, per_cu = 0;
        if (hipGetDevice(&dev) != hipSuccess || hipDeviceGetAttribute(&cus, hipDeviceAttributeMultiprocessorCount, dev) != hipSuccess) { grid = -1; return; }
        if (hipFuncSetAttribute((const void*)mega_fwd, hipFuncAttributeMaxDynamicSharedMemorySize, LDS_BYTES) != hipSuccess) { fprintf(stderr, "kernel_launch: hipFuncSetAttribute failed\n"); grid = -1; return; }
        if (hipOccupancyMaxActiveBlocksPerMultiprocessor(&per_cu, (const void*)mega_fwd, NWAVES * 64, LDS_BYTES) != hipSuccess || per_cu < 1)
            fprintf(stderr, "kernel_launch: note: occupancy query reports %d workgroups per CU\n", per_cu);
        (void)hipGetLastError();
        grid = cus;
    }
    if (grid < 0) return;
    (void)hipMemsetAsync((char*)d_ws + WS_CTL, 0, CTL_ZERO_BYTES, stream);
    Args a{};
    for (int i = 0; i < 21; ++i) a.in[i] = (const float*)d_in[i];
    a.out = (float*)d_out; a.ws = (unsigned char*)d_ws;
    if (MK_N_LAUNCHES == 1) { a.ph_lo = 0; a.ph_hi = PH_COUNT; hipLaunchKernelGGL(mega_fwd, dim3(grid), dim3(NWAVES * 64), LDS_BYTES, stream, a); }
    else for (int p = 0; p < PH_COUNT; ++p) { a.ph_lo = p; a.ph_hi = p + 1; hipLaunchKernelGGL(mega_fwd, dim3(grid), dim3(NWAVES * 64), LDS_BYTES, stream, a); }
}
```

```cpp
#include <hip/hip_runtime.h>
#include <hip/hip_bf16.h>
#include <cstdio>
#include <cstdint>
#include <cmath>
#include <type_traits>

#ifndef WT_STORES
#define WT_STORES 0
#endif
typedef unsigned wt_u32x4 __attribute__((ext_vector_type(4)));
__device__ __forceinline__ void st16_wt(void* p, wt_u32x4 v) {
#if WT_STORES
    asm volatile("global_store_dwordx4 %0, %1, off sc1\n\ts_nop 1" :: "v"(p), "v"(v) : "memory");
#else
    *(wt_u32x4*)p = v;
#endif
}

#ifndef PROBE_SEG
#define PROBE_SEG 0
#endif
#define SEG_T0(n) unsigned long long segt_##n = 0; if (PROBE_SEG == (n)) segt_##n = __builtin_amdgcn_s_memrealtime()
#define SEG_T1(n) do { if (PROBE_SEG == (n)) pr_seg += __builtin_amdgcn_s_memrealtime() - segt_##n; } while (0)
namespace pg8 {
#define PG8_LAS __attribute__((address_space(3)))
typedef unsigned short bf16_t;
typedef short bf16x8 __attribute__((ext_vector_type(8)));
typedef float f32x4 __attribute__((ext_vector_type(4)));
typedef unsigned u32x4 __attribute__((ext_vector_type(4)));
constexpr int BM = 256, BK = 64, HALF = 128, HTB = HALF * BK * 2  , STAGE_BYTES = 8 * HTB, NXCD = 8, WGM = 4;

__host__ __device__ __forceinline__ int lds_byte(int r, int c) { const int st = (r >> 4) * 2 + (c >> 5), rr = r & 15, cc = c & 31, ob = rr * 64 + cc * 2; return st * 1024 + (ob ^ (((ob >> 9) & 1) << 5)); }
__host__ __device__ __forceinline__ void stage_rc(int b, int& R, int& C) { const int st = b / 1024, sb = b % 1024, swz = sb ^ (((sb >> 9) & 1) << 5); R = (st >> 1) * 16 + swz / 64; C = (st & 1) * 32 + (swz % 64) / 2; }
__host__ __device__ __forceinline__ int perm32(int rho) { const int n = rho >> 4, i = rho & 15; return 8 * (i >> 2) + 4 * n + (i & 3); }

struct Unit { int pm, pn; };
struct Gemm { const bf16_t* A; const bf16_t* Bt; int M, N, K; };

struct StaticOrder {
    int nM, nN, nwg, G, c;
    __host__ __device__ void init(int M, int N, int G_, int c_) { nM = M / BM; nN = N / BM; nwg = nM * nN; G = G_; c = c_; }
    __host__ __device__ bool next(int i, Unit& u) const {
        const long L = (long)i * G + c; if (L >= nwg) return false;
        int wgid = (int)L; { const int q = nwg / NXCD, r = nwg % NXCD, xcd = wgid % NXCD, off = wgid / NXCD; wgid = (xcd < r ? xcd * (q + 1) : r * (q + 1) + (xcd - r) * q) + off; }
        const int nig = WGM * nN, gid = wgid / nig, fm = gid * WGM, gsz = (nM - fm) < WGM ? (nM - fm) : WGM;
        u.pm = fm + ((wgid % nig) % gsz); u.pn = (wgid % nig) / gsz; return true;
    }
    __device__ __forceinline__ void a_ready(const Unit&) const {}
    __device__ __forceinline__ void done(const Unit&) const {}
};


__device__ __forceinline__ unsigned cvt_pk_bf16(float lo, float hi) { unsigned r; asm volatile("v_cvt_pk_bf16_f32 %0, %1, %2" : "=v"(r) : "v"(lo), "v"(hi)); return r; }
__device__ __forceinline__ u32x4 pack8(const f32x4 a, const f32x4 b) { u32x4 w; w.x = cvt_pk_bf16(a[0], a[1]); w.y = cvt_pk_bf16(a[2], a[3]); w.z = cvt_pk_bf16(b[0], b[1]); w.w = cvt_pk_bf16(b[2], b[3]); return w; }
constexpr float RMS_EPS = 1e-6f;
constexpr float LOG2E = 1.4426950408889634f;
__device__ __forceinline__ void rstd8(const float* ssq, int row0, float (&rs)[8]) {
    f32x4 p[8];
#pragma unroll
    for (int i = 0; i < 8; ++i) p[i] = *(const f32x4*)(ssq + (size_t)(row0 + (i >> 2) * HALF + (i & 3) * 16) * 4);
#pragma unroll
    for (int i = 0; i < 8; ++i) rs[i] = __builtin_amdgcn_rsqf(((p[i][0] + p[i][1]) + (p[i][2] + p[i][3])) * (1.0f / 1024.0f) + RMS_EPS);
}
__device__ __forceinline__ float silu_f(float x) { return x * __builtin_amdgcn_rcpf(1.0f + __builtin_amdgcn_exp2f(-LOG2E * x)); }
__device__ __forceinline__ f32x4 silu4(f32x4 v) { f32x4 o; o[0] = silu_f(v[0]); o[1] = silu_f(v[1]); o[2] = silu_f(v[2]); o[3] = silu_f(v[3]); return o; }

struct EpiConvIn {
    static constexpr bool PERM = true, AFTER_DRAIN = false;
    bf16_t* cv; const float* ssq;
    __device__ __forceinline__ void operator()(const f32x4 (&acc)[2][2][4][2], const Unit& u, int wr, int wc, int fr, int fq) const {
        const int row0 = u.pm * BM + wr * 64 + fr; float rsv[8]; rstd8(ssq, row0, rsv);
#pragma unroll
        for (int ai = 0; ai < 2; ++ai)
#pragma unroll
            for (int m = 0; m < 4; ++m) { const int row = row0 + ai * HALF + m * 16; const float r2 = rsv[ai * 4 + m] * rsv[ai * 4 + m];
                const f32x4 v0 = acc[ai][0][m][0] * acc[ai][1][m][0] * r2, v1 = acc[ai][0][m][1] * acc[ai][1][m][1] * r2;
                st16_wt(cv + (size_t)row * 1024 + 128 * u.pn + 32 * wc + 8 * fq, pack8(v0, v1)); }
    }
};
struct EpiConvB {
    static constexpr bool PERM = true, AFTER_DRAIN = false;
    const bf16_t* cv; bf16_t* y; const float* ssq; const float* cw; PG8_LAS float* tab;
    __device__ __forceinline__ void operator()(const f32x4 (&acc)[2][2][4][2], const Unit& u, int wr, int wc, int fr, int fq) const {
        const int row0 = u.pm * BM + wr * 64 + fr; float rsv[8]; rstd8(ssq, row0, rsv);
        { const int t = threadIdx.x; if (t < 256) {
#pragma unroll
            for (int k = 0; k < 3; ++k) tab[k * 256 + t] = cw[k * 1024 + 256 * u.pn + t]; } }
        asm volatile("s_waitcnt vmcnt(0) lgkmcnt(0)" ::: "memory"); __builtin_amdgcn_s_barrier(); asm volatile("" ::: "memory");
#pragma unroll
        for (int bj = 0; bj < 2; ++bj) { const int tcol = 128 * bj + 32 * wc + 8 * fq, col = 256 * u.pn + tcol;
#pragma unroll
            for (int ah = 0; ah < 4; ++ah) { const int ai = ah >> 1, mb = (ah & 1) * 2;
                u32x4 raw[2][3];
#pragma unroll
                for (int mm = 0; mm < 2; ++mm) { const int row = row0 + ai * HALF + (mb + mm) * 16; const int t = row & 8191;
#pragma unroll
                    for (int k = 0; k < 3; ++k) raw[mm][k] = (t - 2 + k >= 0) ? *(const u32x4*)(cv + (size_t)(row - 2 + k) * 1024 + col) : (u32x4){0u, 0u, 0u, 0u}; }
#pragma unroll
                for (int mm = 0; mm < 2; ++mm) { const int m = mb + mm; const int row = row0 + ai * HALF + m * 16; const float rs = rsv[ai * 4 + m]; f32x4 o[2];
#pragma unroll
                    for (int n = 0; n < 2; ++n) { f32x4 a = (f32x4){0.f, 0.f, 0.f, 0.f};
#pragma unroll
                        for (int k = 0; k < 3; ++k) { const unsigned lo = n == 0 ? raw[mm][k].x : raw[mm][k].z, hi = n == 0 ? raw[mm][k].y : raw[mm][k].w;
                            const f32x4 xv = (f32x4){__uint_as_float(lo << 16), __uint_as_float(lo & 0xffff0000u), __uint_as_float(hi << 16), __uint_as_float(hi & 0xffff0000u)};
                            a = a + *(const PG8_LAS f32x4*)(tab + k * 256 + tcol + 4 * n) * xv; }
                        o[n] = a * (acc[ai][bj][m][n] * rs); }
                    st16_wt(y + (size_t)row * 1024 + col, pack8(o[0], o[1])); }
                asm volatile("" ::: "memory"); } }
        asm volatile("s_waitcnt lgkmcnt(0)" ::: "memory"); __builtin_amdgcn_s_barrier(); asm volatile("" ::: "memory");
    }
};
struct EpiFoxIn {
    static constexpr bool PERM = true, AFTER_DRAIN = false;
    bf16_t* qkv; const float* ssq; const float* qg; const float* kg; float qscale;
    __device__ __forceinline__ void operator()(const f32x4 (&acc)[2][2][4][2], const Unit& u, int wr, int wc, int fr, int fq) const {
        const int row0 = u.pm * BM + wr * 64 + fr; const int t = u.pn >> 2, head = 4 * (u.pn & 3) + wc; float rsv[8]; rstd8(ssq, row0, rsv);
        bf16_t* base = qkv + (size_t)t * ((size_t)16384 * 1024) + 64 * head + 8 * fq;
        f32x4 g[2][2];
#pragma unroll
        for (int bj = 0; bj < 2; ++bj)
#pragma unroll
            for (int n = 0; n < 2; ++n) { g[bj][n] = (f32x4){1.f, 1.f, 1.f, 1.f};
                if (t < 2) { g[bj][n] = *(const f32x4*)((t == 0 ? qg : kg) + 32 * bj + 8 * fq + 4 * n); if (t == 0) g[bj][n] = g[bj][n] * qscale; } }
#pragma unroll
        for (int ai = 0; ai < 2; ++ai)
#pragma unroll
            for (int m = 0; m < 4; ++m) { const int row = row0 + ai * HALF + m * 16; const float rs = rsv[ai * 4 + m];
                f32x4 v[2][2]; float ss = 0.f;
#pragma unroll
                for (int bj = 0; bj < 2; ++bj)
#pragma unroll
                    for (int n = 0; n < 2; ++n) { v[bj][n] = acc[ai][bj][m][n] * rs; const f32x4 q = v[bj][n] * v[bj][n]; ss += (q[0] + q[1]) + (q[2] + q[3]); }
                if (t < 2) { ss += __shfl_xor(ss, 16); ss += __shfl_xor(ss, 32); const float hr = __builtin_amdgcn_rsqf(ss * (1.0f / 64.0f) + RMS_EPS);
#pragma unroll
                    for (int bj = 0; bj < 2; ++bj)
#pragma unroll
                        for (int n = 0; n < 2; ++n) v[bj][n] = v[bj][n] * g[bj][n] * hr; }
#pragma unroll
                for (int bj = 0; bj < 2; ++bj) st16_wt(base + (size_t)row * 1024 + 32 * bj, pack8(v[bj][0], v[bj][1])); }
    }
};
struct EpiSsdIn {
    static constexpr bool PERM = true, AFTER_DRAIN = false;
    bf16_t* zs; bf16_t* xbc; const float* ssq; bf16_t* halo;
    __device__ __forceinline__ void operator()(const f32x4 (&acc)[2][2][4][2], const Unit& u, int wr, int wc, int fr, int fq) const {
        const int row0 = u.pm * BM + wr * 64 + fr; float rsv[8]; rstd8(ssq, row0, rsv);
#pragma unroll
        for (int ai = 0; ai < 2; ++ai)
#pragma unroll
            for (int m = 0; m < 4; ++m) { const int row = row0 + ai * HALF + m * 16; const float rs = rsv[ai * 4 + m];
#pragma unroll
                for (int bj = 0; bj < 2; ++bj) { f32x4 v0 = acc[ai][bj][m][0] * rs, v1 = acc[ai][bj][m][1] * rs;
                    if (u.pn < 8) { v0 = silu4(v0); v1 = silu4(v1); st16_wt(zs + (size_t)row * 2048 + 256 * u.pn + 128 * bj + 32 * wc + 8 * fq, pack8(v0, v1)); }
                    else { const u32x4 pk = pack8(v0, v1); const int colx = 256 * (u.pn - 8) + 128 * bj + 32 * wc + 8 * fq; st16_wt(xbc + (size_t)row * 4096 + colx, pk);
                        if ((row & 127) >= 125) st16_wt(halo + ((size_t)((row >> 7) + 1) * 3 + ((row & 127) - 125)) * 4096 + colx, pk); } } }
    }
};
struct EpiGU {
    static constexpr bool PERM = true, AFTER_DRAIN = false;
    bf16_t* hb; const float* ssq;
    __device__ __forceinline__ void operator()(const f32x4 (&acc)[2][2][4][2], const Unit& u, int wr, int wc, int fr, int fq) const {
        const int row0 = u.pm * BM + wr * 64 + fr; float rsv[8]; rstd8(ssq, row0, rsv);
#pragma unroll
        for (int ai = 0; ai < 2; ++ai)
#pragma unroll
            for (int m = 0; m < 4; ++m) { const int row = row0 + ai * HALF + m * 16; const float rs = rsv[ai * 4 + m];
                const f32x4 v0 = silu4(acc[ai][0][m][0] * rs) * (acc[ai][1][m][0] * rs), v1 = silu4(acc[ai][0][m][1] * rs) * (acc[ai][1][m][1] * rs);
                st16_wt(hb + (size_t)row * 2816 + 128 * u.pn + 32 * wc + 8 * fq, pack8(v0, v1)); }
    }
};
template <int MODE> struct EpiResid {
    static constexpr bool PERM = true, AFTER_DRAIN = false;
    const float* xin; float* out; bf16_t* xb; float* ssq; PG8_LAS float* tab;
    __device__ __forceinline__ void operator()(const f32x4 (&acc)[2][2][4][2], const Unit& u, int wr, int wc, int fr, int fq) const {
        const int row0 = u.pm * BM + wr * 64 + fr; const int col0 = u.pn * BM + 32 * wc + 8 * fq;
#pragma unroll
        for (int ai = 0; ai < 2; ++ai) {
            f32x4 pre[4][2][2];
#pragma unroll
            for (int m = 0; m < 4; ++m) { const size_t ro = (size_t)(row0 + ai * HALF + m * 16) * 1024 + col0;
#pragma unroll
                for (int bj = 0; bj < 2; ++bj) {
                    if (MODE == 0) { pre[m][bj][0] = *(const f32x4*)(xin + ro + 128 * bj); pre[m][bj][1] = *(const f32x4*)(xin + ro + 128 * bj + 4); }
                    else { const u32x4 w = *(const u32x4*)(xb + ro + 128 * bj);
                        pre[m][bj][0] = (f32x4){__uint_as_float(w.x << 16), __uint_as_float(w.x & 0xffff0000u), __uint_as_float(w.y << 16), __uint_as_float(w.y & 0xffff0000u)};
                        pre[m][bj][1] = (f32x4){__uint_as_float(w.z << 16), __uint_as_float(w.z & 0xffff0000u), __uint_as_float(w.w << 16), __uint_as_float(w.w & 0xffff0000u)}; } } }
#pragma unroll
            for (int m = 0; m < 4; ++m) { const int row = row0 + ai * HALF + m * 16; const size_t ro = (size_t)row * 1024 + col0; float ss = 0.f;
#pragma unroll
                for (int bj = 0; bj < 2; ++bj) { const f32x4 a = pre[m][bj][0] + acc[ai][bj][m][0], b = pre[m][bj][1] + acc[ai][bj][m][1];
                    if (MODE == 2) { *(f32x4*)(out + ro + 128 * bj) = a; *(f32x4*)(out + ro + 128 * bj + 4) = b; }
                    else { const f32x4 qa = a * a, qb = b * b; ss += ((qa[0] + qa[1]) + (qa[2] + qa[3])) + ((qb[0] + qb[1]) + (qb[2] + qb[3]));
                        st16_wt(xb + ro + 128 * bj, pack8(a, b)); } }
                if (MODE != 2) { ss += __shfl_xor(ss, 16); ss += __shfl_xor(ss, 32);
                    if (fq == 0) tab[wc * 256 + (row - u.pm * BM)] = ss; } }
            asm volatile("" ::: "memory"); }
        if (MODE != 2) {
        asm volatile("s_waitcnt lgkmcnt(0)" ::: "memory"); __builtin_amdgcn_s_barrier(); asm volatile("" ::: "memory");
        { const int t = threadIdx.x; if (t < 256) ssq[(size_t)(u.pm * BM + t) * 4 + u.pn] = (tab[t] + tab[256 + t]) + (tab[512 + t] + tab[768 + t]); }
        asm volatile("s_waitcnt lgkmcnt(0)" ::: "memory"); __builtin_amdgcn_s_barrier(); asm volatile("" ::: "memory");
        }
    }
};


template <class Epi, class Sched, bool ALIGN_EPI = false, bool SP2 = false>
__device__ __forceinline__ void gemm_phase(PG8_LAS unsigned char* lds, const Gemm g, const Sched& S, const Epi& E) {
    const int tid = threadIdx.x, wid = __builtin_amdgcn_readfirstlane(tid >> 6), lane = tid & 63, wr = wid >> 2, wc = wid & 3, fr = lane & 15, fq = lane >> 4;
    const int K = g.K, nt = K / BK;
    unsigned voffA[2], voffB[2];
#pragma unroll
    for (int i = 0; i < 2; ++i) { int R, C; stage_rc(tid * 16 + i * 8192, R, C); const int Rb = Epi::PERM ? ((R & ~31) + perm32(R & 31)) : R;
        voffA[i] = (unsigned)(R * K + C) * 2u; voffB[i] = (unsigned)(Rb * K + C) * 2u; }
    const size_t kstep = (size_t)(BK * 2);
    const size_t hstep = (size_t)HALF * K * 2;
    const size_t tstep = 2 * hstep;
    const unsigned ldsw = (unsigned)wid * 1024u;
    const int aoff = lds_byte(wr * 64 + fr, fq * 8), boff = lds_byte(wc * 32 + fr, fq * 8);
#define PG8_SA(b, h) (((b) * 2 + (h)) * HTB)
#define PG8_SB(b, h) ((4 + (b) * 2 + (h)) * HTB)
#define PG8_STAGE(bufoff, gbase, voff) do { _Pragma("unroll") for (int _i = 0; _i < 2; ++_i) \
        __builtin_amdgcn_global_load_lds((const unsigned*)((const char*)(gbase) + (voff)[_i]), (PG8_LAS unsigned*)(lds + (bufoff) + ldsw + _i * 8192), 16, 0, 0); } while (0)
#define PG8_LDA(dst, b, h) do { _Pragma("unroll") for (int m = 0; m < 4; ++m) _Pragma("unroll") for (int k = 0; k < 2; ++k) dst[m][k] = *(const PG8_LAS bf16x8*)(lds + PG8_SA(b, h) + aoff + m * 2048 + k * 1024); } while (0)
#define PG8_LDB(dst, b, h) do { _Pragma("unroll") for (int n = 0; n < 2; ++n) _Pragma("unroll") for (int k = 0; k < 2; ++k) dst[n][k] = *(const PG8_LAS bf16x8*)(lds + PG8_SB(b, h) + boff + n * 2048 + k * 1024); } while (0)
#define PG8_MMA(ai, bj, At, Bt) do { __builtin_amdgcn_s_setprio(1); _Pragma("unroll") for (int m = 0; m < 4; ++m) _Pragma("unroll") for (int n = 0; n < 2; ++n) _Pragma("unroll") for (int k = 0; k < 2; ++k) \
        acc[ai][bj][m][n] = __builtin_amdgcn_mfma_f32_16x16x32_bf16(Bt[n][k], At[m][k], acc[ai][bj][m][n], 0, 0, 0); __builtin_amdgcn_s_setprio(0); } while (0)
#define PG8_WAIT_V(n) asm volatile("s_waitcnt vmcnt(" #n ")" ::: "memory")
#define PG8_WAIT_L(n) asm volatile("s_waitcnt lgkmcnt(" #n ")" ::: "memory")
#define PG8_BAR __builtin_amdgcn_s_barrier()
#define PG8_SCHED __builtin_amdgcn_sched_barrier(0)
    Unit cur, nxt; int ui = 0;
    if (!S.next(0, cur)) return;
    f32x4 acc[2][2][4][2];
#pragma unroll
    for (int a = 0; a < 2; ++a)
#pragma unroll
        for (int b = 0; b < 2; ++b)
#pragma unroll
            for (int m = 0; m < 4; ++m)
#pragma unroll
                for (int n = 0; n < 2; ++n) acc[a][b][m][n] = (f32x4){0.f, 0.f, 0.f, 0.f};
    bf16x8 At[4][2], B0[2][2], B1[2][2];
    const char* cA = (const char*)g.A + (size_t)cur.pm * tstep; const char* cB = (const char*)g.Bt + (size_t)cur.pn * tstep;
    S.a_ready(cur);
    if constexpr (SP2) {
        PG8_STAGE(PG8_SB(0, 0), cB, voffB); PG8_STAGE(PG8_SB(0, 1), cB + hstep, voffB); PG8_STAGE(PG8_SA(0, 0), cA, voffA); PG8_STAGE(PG8_SA(0, 1), cA + hstep, voffA);
        if (wr == 1) PG8_BAR;
        PG8_WAIT_V(2); PG8_BAR;
        PG8_STAGE(PG8_SB(1, 0), cB + kstep, voffB); PG8_STAGE(PG8_SA(1, 0), cA + kstep, voffA); PG8_STAGE(PG8_SB(1, 1), cB + hstep + kstep, voffB);
        PG8_WAIT_V(6); PG8_BAR;
    } else {
        PG8_STAGE(PG8_SB(0, 0), cB, voffB); PG8_STAGE(PG8_SA(0, 0), cA, voffA); PG8_STAGE(PG8_SB(0, 1), cB + hstep, voffB); PG8_STAGE(PG8_SA(0, 1), cA + hstep, voffA);
        if (wr == 1) PG8_BAR;
        PG8_WAIT_V(4); PG8_BAR;
        PG8_STAGE(PG8_SB(1, 0), cB + kstep, voffB); PG8_STAGE(PG8_SA(1, 0), cA + kstep, voffA); PG8_STAGE(PG8_SB(1, 1), cB + hstep + kstep, voffB);
        PG8_WAIT_V(6); PG8_BAR;
    }
    for (;;) {
        const bool has_next = S.next(ui + 1, nxt);
        const char* nA = has_next ? (const char*)g.A + (size_t)nxt.pm * tstep : cA; const char* nB = has_next ? (const char*)g.Bt + (size_t)nxt.pn * tstep : cB;
        unsigned long long kt0_ = 0; if (PROBE_SEG == 5) kt0_ = __builtin_amdgcn_s_memrealtime(); if (PROBE_SEG == 6) kt0_ = __builtin_amdgcn_s_memtime();
        for (int t = 0; t < nt; t += 2) {
            const bool last = (t == nt - 2);
            const char* a1 = cA + (size_t)(t + 1) * kstep;
            const char* a2 = last ? nA : cA + (size_t)(t + 2) * kstep; const char* b2 = last ? nB : cB + (size_t)(t + 2) * kstep;
            const char* a3 = a2 + kstep; const char* b3 = b2 + kstep;
            if (last && has_next) S.a_ready(nxt);
            if constexpr (SP2) {
            PG8_LDB(B0, 0, 0); PG8_LDB(B1, 0, 1); PG8_SCHED; PG8_LDA(At, 0, 0); PG8_STAGE(PG8_SA(1, 1), a1 + hstep, voffA);
            PG8_WAIT_V(8); PG8_WAIT_L(0); PG8_BAR; PG8_MMA(0, 0, At, B0); PG8_MMA(0, 1, At, B1); PG8_BAR; PG8_SCHED;
            PG8_LDA(At, 0, 1); PG8_STAGE(PG8_SB(0, 0), b2, voffB); PG8_STAGE(PG8_SB(0, 1), b2 + hstep, voffB); PG8_STAGE(PG8_SA(0, 0), a2, voffA);
            PG8_WAIT_V(8); PG8_WAIT_L(0); PG8_BAR; PG8_MMA(1, 0, At, B0); PG8_MMA(1, 1, At, B1); PG8_BAR; PG8_SCHED;
            PG8_LDB(B0, 1, 0); PG8_LDB(B1, 1, 1); PG8_SCHED; PG8_LDA(At, 1, 0); PG8_STAGE(PG8_SA(0, 1), a2 + hstep, voffA);
            PG8_WAIT_V(8); PG8_WAIT_L(0); PG8_BAR; PG8_MMA(0, 0, At, B0); PG8_MMA(0, 1, At, B1); PG8_BAR; PG8_SCHED;
            PG8_LDA(At, 1, 1); PG8_STAGE(PG8_SB(1, 0), b3, voffB); PG8_STAGE(PG8_SB(1, 1), b3 + hstep, voffB); PG8_STAGE(PG8_SA(1, 0), a3, voffA);
            PG8_WAIT_V(8); PG8_WAIT_L(0); PG8_BAR; PG8_MMA(1, 0, At, B0); PG8_MMA(1, 1, At, B1); PG8_BAR; PG8_SCHED;
            } else {
            PG8_LDB(B0, 0, 0); PG8_SCHED; PG8_LDA(At, 0, 0); PG8_STAGE(PG8_SA(1, 1), a1 + hstep, voffA);
            PG8_WAIT_L(8); PG8_BAR; PG8_WAIT_L(0); PG8_MMA(0, 0, At, B0); PG8_BAR; PG8_SCHED;
            PG8_LDB(B1, 0, 1); PG8_STAGE(PG8_SB(0, 0), b2, voffB);
            PG8_BAR; PG8_WAIT_L(0); PG8_MMA(0, 1, At, B1); PG8_BAR;
            PG8_LDA(At, 0, 1); PG8_STAGE(PG8_SA(0, 0), a2, voffA);
            PG8_BAR; PG8_WAIT_L(0); PG8_MMA(1, 0, At, B0); PG8_BAR; PG8_SCHED;
            PG8_STAGE(PG8_SB(0, 1), b2 + hstep, voffB);
            PG8_WAIT_V(6); PG8_BAR; PG8_MMA(1, 1, At, B1); PG8_BAR;
            PG8_LDB(B0, 1, 0); PG8_SCHED; PG8_LDA(At, 1, 0); PG8_STAGE(PG8_SA(0, 1), a2 + hstep, voffA);
            PG8_WAIT_L(8); PG8_BAR; PG8_WAIT_L(0); PG8_MMA(0, 0, At, B0); PG8_BAR; PG8_SCHED;
            PG8_LDB(B1, 1, 1); PG8_STAGE(PG8_SB(1, 0), b3, voffB);
            PG8_BAR; PG8_WAIT_L(0); PG8_MMA(0, 1, At, B1); PG8_BAR;
            PG8_LDA(At, 1, 1); PG8_STAGE(PG8_SA(1, 0), a3, voffA);
            PG8_BAR; PG8_WAIT_L(0); PG8_MMA(1, 0, At, B0); PG8_BAR; PG8_SCHED;
            PG8_STAGE(PG8_SB(1, 1), b3 + hstep, voffB);
            PG8_WAIT_V(6); PG8_BAR; PG8_MMA(1, 1, At, B1); PG8_BAR;
            }
        }
        if (PROBE_SEG == 5 || PROBE_SEG == 6) { const unsigned long long kt1_ = (PROBE_SEG == 5) ? __builtin_amdgcn_s_memrealtime() : __builtin_amdgcn_s_memtime(); if (tid == 0) *(PG8_LAS unsigned long long*)(lds + 146432 + 64) += (PROBE_SEG == 5) ? (kt1_ - kt0_) : (kt1_ - kt0_) / 20; }
        if constexpr (ALIGN_EPI) { if (wr == 0) PG8_BAR; }
        if constexpr (!Epi::AFTER_DRAIN) { E(acc, cur, wr, wc, fr, fq); S.done(cur); }
        if (!has_next) break;
#pragma unroll
        for (int a = 0; a < 2; ++a)
#pragma unroll
            for (int b = 0; b < 2; ++b)
#pragma unroll
                for (int m = 0; m < 4; ++m)
#pragma unroll
                    for (int n = 0; n < 2; ++n) acc[a][b][m][n] = (f32x4){0.f, 0.f, 0.f, 0.f};
        cur = nxt; cA = nA; cB = nB; ++ui;
        if constexpr (ALIGN_EPI) { if (wr == 1) PG8_BAR; }
    }
    PG8_WAIT_V(0);
    if constexpr (!ALIGN_EPI) { if (wr == 0) PG8_BAR; }
    PG8_BAR;
    if constexpr (Epi::AFTER_DRAIN) { E.fused(acc, cur, wr, wc, fr, fq, lds, wid, lane); S.done(cur); }
#undef PG8_SA
#undef PG8_SB
#undef PG8_STAGE
#undef PG8_LDA
#undef PG8_LDB
#undef PG8_MMA
#undef PG8_WAIT_V
#undef PG8_WAIT_L
#undef PG8_BAR
#undef PG8_SCHED
}
}

namespace attn {
typedef unsigned short bf16_t;
using bf16x8 = __attribute__((ext_vector_type(8))) short;
using s16x4 = __attribute__((ext_vector_type(4))) short;
using f32x16 = __attribute__((ext_vector_type(16))) float;
using u32x4 = __attribute__((ext_vector_type(4))) unsigned;
constexpr int SEQ = 8192, DM = 1024, NW = 8, QBLK = 32, QB = 256, KVBLK = 64;
constexpr int SLOTB = 8192;
constexpr int NSLOT = 3;
constexpr int LDS_K = 0, LDS_V = NSLOT * SLOTB, LDS_KX = 2 * NSLOT * SLOTB, LDS_WS = LDS_KX + NSLOT * 1024, LDS_OST = LDS_WS + NW * 256, LDS_BYTES = LDS_OST + NW * 4096;
__device__ __forceinline__ int crow(int r, int hi) { return (r & 3) + 8 * (r >> 2) + 4 * hi; }
#define SBAR() __builtin_amdgcn_sched_barrier(0)
__device__ __forceinline__ void cmask(f32x16& p0, f32x16& p1, int jb, int qrel, int hi) {
    const float NEG = -INFINITY; const int kb = 64 * jb + 4 * hi;
#pragma unroll
    for (int r = 0; r < 16; ++r) { const int kv = kb + (r & 3) + 8 * (r >> 2); if (kv > qrel) p0[r] = NEG; if (kv + 32 > qrel) p1[r] = NEG; }
}
__device__ __forceinline__ void glds16(const void* gsrc, unsigned lds_dst) { unsigned keep;
    asm volatile("s_mov_b32 %0, m0\n\ts_mov_b32 m0, %2\n\ts_nop 0\n\tglobal_load_lds_dwordx4 %1, off\n\ts_mov_b32 m0, %0" : "=&s"(keep) : "v"(gsrc), "s"(lds_dst) : "memory"); }
typedef float f32x2_t __attribute__((ext_vector_type(2))); typedef __bf16 bf16x2_t __attribute__((ext_vector_type(2)));
__device__ __forceinline__ unsigned cvtpk_s(float lo, float hi) { f32x2_t v = {lo, hi}; bf16x2_t b = __builtin_convertvector(v, bf16x2_t); return __builtin_bit_cast(unsigned, b); }
__device__ __forceinline__ void pv(f32x16* o, int vb, bf16x8 pa0, bf16x8 pa1, bf16x8 pa2, bf16x8 pa3) {
#pragma unroll
    for (int d0 = 0; d0 < 2; ++d0) { s16x4 lo[4], hi[4];
#pragma unroll
        for (int ks = 0; ks < 4; ++ks) {
            asm volatile("ds_read_b64_tr_b16 %0,%1 offset:%c2" : "=&v"(lo[ks]) : "v"(vb), "i"(d0 * 4096 + ks * 1024) : "memory");
            asm volatile("ds_read_b64_tr_b16 %0,%1 offset:%c2" : "=&v"(hi[ks]) : "v"(vb), "i"(d0 * 4096 + ks * 1024 + 512) : "memory"); }
        asm volatile("s_waitcnt lgkmcnt(0)" ::: "memory"); SBAR();
#define PK(k) (bf16x8){lo[k][0], lo[k][1], lo[k][2], lo[k][3], hi[k][0], hi[k][1], hi[k][2], hi[k][3]}
        o[d0] = __builtin_amdgcn_mfma_f32_32x32x16_bf16(pa0, PK(0), o[d0], 0, 0, 0);
        o[d0] = __builtin_amdgcn_mfma_f32_32x32x16_bf16(pa1, PK(1), o[d0], 0, 0, 0);
        o[d0] = __builtin_amdgcn_mfma_f32_32x32x16_bf16(pa2, PK(2), o[d0], 0, 0, 0);
        o[d0] = __builtin_amdgcn_mfma_f32_32x32x16_bf16(pa3, PK(3), o[d0], 0, 0, 0);
#undef PK
    }
}
__device__ __forceinline__ int first_tile(const float* tlh, int qb, float limit, int lane) {
    const int tb = 4 * qb; if (tb == 0) return 0;
    const int t = tb - 1 - lane;
    float P = (t >= 0) ? __hip_atomic_load(tlh + (t >= 0 ? t : 0), __ATOMIC_RELAXED, __HIP_MEMORY_SCOPE_AGENT) : -1e30f;
#pragma unroll
    for (int o = 1; o < 64; o <<= 1) { const float u = __shfl_up(P, o); if (lane >= o) P += u; }
    float Dp = __shfl_up(P, 1); if (lane == 0) Dp = 0.f;
    const bool inc = (t >= 0) && (Dp >= -limit);
    const int n = __popcll(__ballot(inc));
    int tf = tb - n; if (n == 64 && tb > 64) tf = 0;
    return __builtin_amdgcn_readfirstlane(tf);
}
__device__ __forceinline__ void tile_offsets(const float* tlh, int NT, int lane, float& Dlo, float& Dhi) {
    const int t0 = NT - 1 - lane, t1 = NT - 65 - lane;
    const float T0 = (t0 >= 0) ? __hip_atomic_load(tlh + (t0 >= 0 ? t0 : 0), __ATOMIC_RELAXED, __HIP_MEMORY_SCOPE_AGENT) : 0.f;
    const float T1 = (t1 >= 0) ? __hip_atomic_load(tlh + (t1 >= 0 ? t1 : 0), __ATOMIC_RELAXED, __HIP_MEMORY_SCOPE_AGENT) : 0.f;
    float P0 = T0, P1 = T1;
#pragma unroll
    for (int o = 1; o < 64; o <<= 1) { const float u0 = __shfl_up(P0, o), u1 = __shfl_up(P1, o); if (lane >= o) { P0 += u0; P1 += u1; } }
    Dlo = P0 - T0; Dhi = __shfl(P0, 63) + (P1 - T1);
}
__device__ __forceinline__ void attn_unit(int b, int h, int qb, int tfirst, const bf16_t* Q, const bf16_t* K, const bf16_t* V, bf16_t* O, const bf16_t* kx, const float* gt, char* shm) {
    const int tid = threadIdx.x, lane = tid & 63, r32 = lane & 31, hi = lane >> 5; const int wid = __builtin_amdgcn_readfirstlane(tid >> 6);
    const long rowbase = (long)b * SEQ; const int q0 = qb * QB; const int bh = b * 16 + h;
    const bf16_t* Qw = Q + (rowbase + q0 + wid * QBLK) * DM + h * 64;
    const bf16_t* Kh = K + rowbase * DM + h * 64; const bf16_t* Vh = V + rowbase * DM + h * 64;
    const bf16_t* kxh = kx + (size_t)bh * SEQ * 8;
    const unsigned lds0 = (unsigned)(uintptr_t)shm;
    float* wsf = (float*)(shm + LDS_WS) + wid * 64;
    const int krow = 8 * wid + (lane >> 3);
    const bf16_t* ksrc = Kh + (long)krow * DM + (((lane & 7) ^ (krow & 7) ^ ((krow >> 4) & 1)) * 8);
    const bf16_t* vsrc = Vh + (long)(16 * (wid & 3) + (lane >> 2)) * DM + (wid >> 2) * 32 + (lane & 3) * 8;
    const bf16_t* xsrc = kxh + (long)lane * 8;
    const unsigned kdst = lds0 + LDS_K + wid * 1024, vdst = lds0 + LDS_V + wid * 1024, xdst = lds0 + LDS_KX;
    const int vb0 = (int)(lds0 + LDS_V) + ((lane >> 4) & 1) * 32 + (lane & 3) * 8 + (4 * hi + ((lane & 15) >> 2)) * 64;
    const int NT = (q0 + QB) / KVBLK;
    bf16x8 qr[4];
#pragma unroll
    for (int d0 = 0; d0 < 4; ++d0) qr[d0] = *reinterpret_cast<const bf16x8*>(&Qw[(long)r32 * DM + d0 * 16 + hi * 8]);
    float Dlo, Dhi; tile_offsets(gt + bh * 128, NT, lane, Dlo, Dhi);
    float l_reg = 0.f; f32x16 o[2]; o[0] = f32x16{}; o[1] = f32x16{};
    const int qrel = wid * QBLK + r32;
#define DMA_TILE(t, s) do { glds16(ksrc + (long)(t) * KVBLK * DM, (unsigned)__builtin_amdgcn_readfirstlane(kdst + (s) * SLOTB)); \
        glds16(vsrc + (long)(t) * KVBLK * DM, (unsigned)__builtin_amdgcn_readfirstlane(vdst + (s) * SLOTB)); \
        if (wid == 0) glds16(xsrc + (long)(t) * KVBLK * 8, (unsigned)__builtin_amdgcn_readfirstlane(xdst + (s) * 1024)); } while (0)
    DMA_TILE(tfirst, 0); if (tfirst + 1 < NT) DMA_TILE(tfirst + 1, 1);
    int s = 0;
    for (int t = tfirst; t < NT; ++t) {
        if (t + 1 < NT) { if (wid == 0) asm volatile("s_waitcnt vmcnt(3) lgkmcnt(0)" ::: "memory"); else asm volatile("s_waitcnt vmcnt(2) lgkmcnt(0)" ::: "memory"); }
        else asm volatile("s_waitcnt vmcnt(0) lgkmcnt(0)" ::: "memory");
        __builtin_amdgcn_s_barrier(); asm volatile("" ::: "memory");
        if (t + 2 < NT) { const int s2 = (s == 0) ? 2 : s - 1; DMA_TILE(t + 2, s2); }
        bf16x8 qx;
        { const int ti = NT - 1 - t; const float D = __builtin_bit_cast(float, ti < 64 ? __builtin_amdgcn_readlane(__builtin_bit_cast(int, Dlo), ti) : __builtin_amdgcn_readlane(__builtin_bit_cast(int, Dhi), ti - 64));
          const unsigned h1 = cvtpk_s(D, D) & 0xffffu; const float r1 = D - __uint_as_float(h1 << 16);
          const unsigned h2 = cvtpk_s(r1, r1) & 0xffffu; const float r2 = r1 - __uint_as_float(h2 << 16);
          const unsigned h3 = cvtpk_s(r2, r2) & 0xffffu;
          u32x4 qw = (u32x4){0u, 0u, 0u, 0u}; if (hi == 0) { qw.x = 0x3F803F80u; qw.y = 0x3F80u | (h1 << 16); qw.z = h2 | (h3 << 16); }
          qx = __builtin_bit_cast(bf16x8, qw); }
        f32x16 p0, p1;
        { const char* kb = shm + LDS_K + s * SLOTB + r32 * 128; const int ksw = (r32 & 7) ^ ((r32 >> 4) & 1); const char* xb = shm + LDS_KX + s * 1024 + r32 * 16;
          const bf16x8 x0 = *reinterpret_cast<const bf16x8*>(xb), x1 = *reinterpret_cast<const bf16x8*>(xb + 512);
          p0 = __builtin_amdgcn_mfma_f32_32x32x16_bf16(x0, qx, f32x16{}, 0, 0, 0); p1 = __builtin_amdgcn_mfma_f32_32x32x16_bf16(x1, qx, f32x16{}, 0, 0, 0);
#pragma unroll
          for (int d0 = 0; d0 < 4; ++d0) { const int ko = ((2 * d0 + hi) ^ ksw) * 16; const bf16x8 b0 = *reinterpret_cast<const bf16x8*>(kb + ko), b1 = *reinterpret_cast<const bf16x8*>(kb + ko + 4096);
              p0 = __builtin_amdgcn_mfma_f32_32x32x16_bf16(b0, qr[d0], p0, 0, 0, 0); p1 = __builtin_amdgcn_mfma_f32_32x32x16_bf16(b1, qr[d0], p1, 0, 0, 0); } }
        { const int jb = t - (NT - 4); if (jb >= 0) cmask(p0, p1, jb, qrel, hi); }
        float sacc = 0.f;
#pragma unroll
        for (int r = 0; r < 16; ++r) { p0[r] = __builtin_amdgcn_exp2f(p0[r]); p1[r] = __builtin_amdgcn_exp2f(p1[r]); sacc += p0[r] + p1[r]; }
        l_reg += sacc;
        u32x4 pw0, pw1, pw2, pw3;
#define PKW(P, B) cvtpk_s(P[B], P[B + 1])
        pw0 = (u32x4){PKW(p0, 0), PKW(p0, 2), PKW(p0, 4), PKW(p0, 6)}; pw1 = (u32x4){PKW(p0, 8), PKW(p0, 10), PKW(p0, 12), PKW(p0, 14)};
        pw2 = (u32x4){PKW(p1, 0), PKW(p1, 2), PKW(p1, 4), PKW(p1, 6)}; pw3 = (u32x4){PKW(p1, 8), PKW(p1, 10), PKW(p1, 12), PKW(p1, 14)};
#undef PKW
        SBAR();
        pv(o, vb0 + s * SLOTB, __builtin_bit_cast(bf16x8, pw0), __builtin_bit_cast(bf16x8, pw1), __builtin_bit_cast(bf16x8, pw2), __builtin_bit_cast(bf16x8, pw3));
        s = (s == 2) ? 0 : s + 1;
    }
#undef DMA_TILE
    { auto rr = __builtin_amdgcn_permlane32_swap(__float_as_uint(l_reg), __float_as_uint(l_reg), false, false); l_reg = __uint_as_float(rr[0]) + __uint_as_float(rr[1]); }
    if (hi == 0) wsf[32 + r32] = l_reg; asm volatile("s_waitcnt lgkmcnt(0)" ::: "memory");
    float rli[16];
#pragma unroll
    for (int r = 0; r < 16; ++r) rli[r] = __builtin_amdgcn_rcpf(wsf[32 + crow(r, hi)]);
    bf16_t* Ow = O + (rowbase + q0 + wid * QBLK) * DM + h * 64;
    { __hip_bfloat16* stg = (__hip_bfloat16*)(shm + LDS_OST) + wid * 2048;
#pragma unroll
      for (int r = 0; r < 16; ++r) { const int orow = crow(r, hi);
#pragma unroll
          for (int d0 = 0; d0 < 2; ++d0) stg[orow * 64 + d0 * 32 + r32] = __float2bfloat16(o[d0][r] * rli[r]); }
      asm volatile("s_waitcnt lgkmcnt(0)" ::: "memory");
#pragma unroll
      for (int i = 0; i < 4; ++i) { const int row = i * 8 + (lane >> 3), ch = lane & 7; const u32x4 v = *(const u32x4*)(stg + row * 64 + ch * 8); st16_wt(Ow + (long)row * DM + ch * 8, v); } }
    asm volatile("s_waitcnt lgkmcnt(0)\n\ts_barrier" ::: "memory");
}
#undef SBAR
}

namespace ssd {
typedef unsigned short bf16_t;
using bf16x8 = __attribute__((ext_vector_type(8))) short;
using s16x4 = __attribute__((ext_vector_type(4))) short;
using f32x16 = __attribute__((ext_vector_type(16))) float;
using f32x4 = __attribute__((ext_vector_type(4))) float;
using u32x4 = __attribute__((ext_vector_type(4))) unsigned;
using u32x2 = __attribute__((ext_vector_type(2))) unsigned;
constexpr int SEQ = 8192, L = 128, NCH = 64, XBC = 4096;
constexpr float LOG2E = 1.4426950408889634f;
typedef __attribute__((address_space(3))) unsigned char* lptr;
#define SSD_LF const __attribute__((address_space(3))) float*
__device__ __forceinline__ int crow(int r, int hi) { return (r & 3) + 8 * (r >> 2) + 4 * hi; }
__device__ __forceinline__ unsigned cvtpk(float lo, float hi) { unsigned r; asm volatile("v_cvt_pk_bf16_f32 %0, %1, %2" : "=v"(r) : "v"(lo), "v"(hi)); return r; }
__device__ __forceinline__ float silu_f(float x) { return x * __builtin_amdgcn_rcpf(1.0f + __builtin_amdgcn_exp2f(-LOG2E * x)); }
__device__ __forceinline__ s16x4 vtr(lptr p) { typedef short v4i16_t __attribute__((ext_vector_type(4))); return __builtin_bit_cast(s16x4, __builtin_amdgcn_ds_read_tr16_b64_v4i16((__attribute__((address_space(3))) v4i16_t*)p)); }
#define SSD_BAR() do { asm volatile("s_waitcnt vmcnt(0) lgkmcnt(0)" ::: "memory"); __builtin_amdgcn_s_barrier(); asm volatile("" ::: "memory"); } while (0)
__device__ __forceinline__ void glds16(const void* gsrc, unsigned lds_dst) { unsigned keep;
    asm volatile("s_mov_b32 %0, m0\n\ts_mov_b32 m0, %2\n\ts_nop 0\n\tglobal_load_lds_dwordx4 %1, off\n\ts_mov_b32 m0, %0" : "=&s"(keep) : "v"(gsrc), "s"(lds_dst) : "memory"); }
__device__ __forceinline__ void glds16s(const void* sbase, unsigned voff, unsigned lds_dst) { unsigned keep;
    asm volatile("s_mov_b32 %0, m0\n\ts_mov_b32 m0, %2\n\ts_nop 0\n\tglobal_load_lds_dwordx4 %1, %3\n\ts_mov_b32 m0, %0" : "=&s"(keep) : "v"(voff), "s"(lds_dst), "s"(sbase) : "memory"); }

constexpr int IMG_X = 0;
constexpr int IMG_B = 65536;
constexpr int IMG_C = 98304;
constexpr int TAB = 131072;
constexpr int TAB_AC = TAB, TAB_DT = TAB + 2048, TAB_SS = TAB + 6144, TAB_NW = TAB + 8192, TAB_MISC = TAB + 9216;

struct Raw11 { u32x4 r[11]; };
__device__ __forceinline__ void raw_load(Raw11& R, const bf16_t* xb_batch, const bf16_t* halo3  , int t0, int rg, int ch) {
#pragma unroll
    for (int i = 0; i < 3; ++i) { if (rg != 0) R.r[i] = *(const u32x4*)(xb_batch + (size_t)(t0 - 3 + i) * XBC + ch); else R.r[i] = halo3 ? *(const u32x4*)(halo3 + (size_t)i * XBC + ch) : (u32x4){0u, 0u, 0u, 0u}; }
#pragma unroll
    for (int i = 0; i < 8; ++i) R.r[3 + i] = *(const u32x4*)(xb_batch + (size_t)(t0 + i) * XBC + ch);
}
__device__ __forceinline__ void conv_rows(const Raw11& R, int ch, const float* cw, const float* cb, float (&out)[8][8]) {
    f32x4 w[4][2], bias[2];
#pragma unroll
    for (int k = 0; k < 4; ++k) { w[k][0] = *(const f32x4*)(cw + k * XBC + ch); w[k][1] = *(const f32x4*)(cw + k * XBC + ch + 4); }
    bias[0] = *(const f32x4*)(cb + ch); bias[1] = *(const f32x4*)(cb + ch + 4);
#pragma unroll
    for (int r = 0; r < 8; ++r)
#pragma unroll
        for (int j = 0; j < 8; ++j) { float a = bias[j >> 2][j & 3];
#pragma unroll
            for (int k = 0; k < 4; ++k) { const unsigned wd = R.r[r + k][j >> 1]; const float xv = (j & 1) ? __uint_as_float(wd & 0xffff0000u) : __uint_as_float(wd << 16); a += w[k][j >> 2][j & 3] * xv; }
            out[r][j] = silu_f(a); }
}
__device__ __forceinline__ void tables_load(lptr lds, const float* dt, const float* acl, const float* tot, int row0, int g, int tid) {
    if (tid < 128) { const f32x4 d = *(const f32x4*)(dt + (size_t)(row0 + tid) * 32 + 4 * g); f32x4 a = *(const f32x4*)(acl + (size_t)(row0 + tid) * 32 + 4 * g);
        if (tid >= 64) a = a + *(const f32x4*)(tot + (size_t)(row0 >> 6) * 32 + 4 * g);
        __attribute__((address_space(3))) float* ac = (__attribute__((address_space(3))) float*)(lds + TAB_AC); __attribute__((address_space(3))) float* dtt = (__attribute__((address_space(3))) float*)(lds + TAB_DT);
#pragma unroll
        for (int k = 0; k < 4; ++k) { ac[k * 128 + tid] = a[k]; dtt[k * 128 + tid] = d[k]; } }
}

__device__ __forceinline__ void s2_unit(lptr lds, int b, int c, int g, bf16_t* xbc, const bf16_t* halo, const float* dt, const float* acl, const float* tot, const float* cw, const float* cb, bf16_t* st_b, float* cdec) {
    const int tid = threadIdx.x, lane = tid & 63, r32 = lane & 31, hi = lane >> 5; const int wid = __builtin_amdgcn_readfirstlane(tid >> 6);
    const int row0 = b * SEQ + c * L; bf16_t* xbat = xbc + (size_t)b * SEQ * XBC; const bf16_t* halo3 = (c > 0) ? halo + (size_t)(row0 >> 7) * 3 * XBC : nullptr;
    const int cg1 = tid & 31, rg1 = tid >> 5, ch1 = 256 * g + 8 * cg1;
    const int cg2 = tid & 15, rg2 = (tid & 255) >> 4, isC = tid >> 8, ch2 = 2048 + 1024 * isC + 128 * g + 8 * cg2;
    u32x4 pk1[8], pk2[8];
    { Raw11 R1; raw_load(R1, xbat, halo3, c * L + rg1 * 8, rg1, ch1);
      const int k = cg1 >> 3, hcol = 4 * g + k;
      float wl[8];
      { const float ta = acl[(size_t)(row0 + 127) * 32 + hcol] + tot[(size_t)(row0 >> 6) * 32 + hcol];
        const float t0h = (rg1 >= 8) ? tot[(size_t)(row0 >> 6) * 32 + hcol] : 0.f;
#pragma unroll
        for (int r = 0; r < 8; ++r) { const size_t ro = (size_t)(row0 + rg1 * 8 + r) * 32 + hcol; wl[r] = __builtin_amdgcn_exp2f(ta - (acl[ro] + t0h)) * dt[ro]; } }
      float out[8][8]; conv_rows(R1, ch1, cw, cb, out);
#pragma unroll
      for (int r = 0; r < 8; ++r) { const int l = rg1 * 8 + r; const float w = wl[r];
          pk1[r].x = cvtpk(out[r][0], out[r][1]); pk1[r].y = cvtpk(out[r][2], out[r][3]); pk1[r].z = cvtpk(out[r][4], out[r][5]); pk1[r].w = cvtpk(out[r][6], out[r][7]);
          u32x4 sx; sx.x = cvtpk(out[r][0] * w, out[r][1] * w); sx.y = cvtpk(out[r][2] * w, out[r][3] * w); sx.z = cvtpk(out[r][4] * w, out[r][5] * w); sx.w = cvtpk(out[r][6] * w, out[r][7] * w);
          *(__attribute__((address_space(3))) u32x4*)(lds + IMG_X + (cg1 >> 2) * 8192 + l * 64 + (cg1 & 3) * 16) = sx; } }
    { Raw11 R2; raw_load(R2, xbat, halo3, c * L + rg2 * 8, rg2, ch2);
      float out[8][8]; conv_rows(R2, ch2, cw, cb, out);
#pragma unroll
      for (int r = 0; r < 8; ++r) { const int l = rg2 * 8 + r;
          pk2[r].x = cvtpk(out[r][0], out[r][1]); pk2[r].y = cvtpk(out[r][2], out[r][3]); pk2[r].z = cvtpk(out[r][4], out[r][5]); pk2[r].w = cvtpk(out[r][6], out[r][7]);
          if (!isC) *(__attribute__((address_space(3))) u32x4*)(lds + IMG_B + (cg2 >> 2) * 8192 + l * 64 + (cg2 & 3) * 16) = pk2[r]; } }
    if (tid < 4) { const int hcol = 4 * g + tid; cdec[(size_t)(b * NCH + c) * 32 + hcol] = __builtin_amdgcn_exp2f(acl[(size_t)(row0 + 127) * 32 + hcol] + tot[(size_t)(row0 >> 6) * 32 + hcol]); }
    SSD_BAR();
#pragma unroll
    for (int r = 0; r < 8; ++r) { st16_wt(xbat + (size_t)(c * L + rg1 * 8 + r) * XBC + ch1, pk1[r]); st16_wt(xbat + (size_t)(c * L + rg2 * 8 + r) * XBC + ch2, pk2[r]); }
    const int k = wid >> 1, nh = wid & 1;
    f32x16 acc[2][2];
#pragma unroll
    for (int i = 0; i < 2; ++i)
#pragma unroll
        for (int j = 0; j < 2; ++j) acc[i][j] = f32x16{};
    const int lanepat = (4 * hi + ((lane & 15) >> 2)) * 64 + ((lane >> 4) & 1) * 32 + (lane & 3) * 8;
#pragma unroll 2
    for (int ks = 0; ks < 8; ++ks) {
        bf16x8 af[2], bf[2];
#pragma unroll
        for (int i = 0; i < 2; ++i) { const lptr pa = lds + IMG_B + (2 * nh + i) * 8192 + ks * 1024 + lanepat; const s16x4 lo = vtr(pa), hh = vtr(pa + 512); af[i] = (bf16x8){lo[0], lo[1], lo[2], lo[3], hh[0], hh[1], hh[2], hh[3]};
                                      const lptr pb = lds + IMG_X + (2 * k + i) * 8192 + ks * 1024 + lanepat; const s16x4 lo2 = vtr(pb), hh2 = vtr(pb + 512); bf[i] = (bf16x8){lo2[0], lo2[1], lo2[2], lo2[3], hh2[0], hh2[1], hh2[2], hh2[3]}; }
#pragma unroll
        for (int i = 0; i < 2; ++i)
#pragma unroll
            for (int j = 0; j < 2; ++j) acc[i][j] = __builtin_amdgcn_mfma_f32_32x32x16_bf16(af[i], bf[j], acc[i][j], 0, 0, 0);
    }
    SSD_BAR();
#pragma unroll
    for (int i = 0; i < 2; ++i)
#pragma unroll
        for (int j = 0; j < 2; ++j)
#pragma unroll
            for (int rq = 0; rq < 4; ++rq) {
                u32x2 o; o.x = cvtpk(acc[i][j][4 * rq], acc[i][j][4 * rq + 1]); o.y = cvtpk(acc[i][j][4 * rq + 2], acc[i][j][4 * rq + 3]);
                *(__attribute__((address_space(3))) u32x2*)(lds + IMG_X + k * 16384 + (((j * 8 + 4 * nh + 2 * i + (rq >> 1)) * 64 + 32 * (rq & 1) + r32) * 16) + 8 * hi) = o; }
    SSD_BAR();
    { bf16_t* dst = st_b + ((size_t)c * 32 + 4 * g) * 8192;
#pragma unroll
      for (int i = 0; i < 8; ++i) { const int off = (i * 512 + tid) * 16; st16_wt((char*)dst + off, *(const __attribute__((address_space(3))) u32x4*)(lds + IMG_X + off)); } }
    asm volatile("s_waitcnt lgkmcnt(0)" ::: "memory"); __builtin_amdgcn_s_barrier(); asm volatile("" ::: "memory");
}

__device__ __forceinline__ void s3_scan(bf16_t* st0, bf16_t* st1, const float* cdec, int vcu, int G) {
    const int tid = threadIdx.x;
    for (int item = vcu; item < 256; item += G) {
        const int b = item >> 7, h = (item >> 2) & 31, qd = item & 3;
        bf16_t* base = (b == 0 ? st0 : st1) + (size_t)h * 8192 + qd * 2048 + tid * 4;
        const float* dc = cdec + (size_t)b * NCH * 32 + h;
        float hs[4] = {0.f, 0.f, 0.f, 0.f};
#pragma unroll 1
        for (int c0 = 0; c0 < NCH; c0 += 8) {
            u32x2 v[8]; float d[8];
#pragma unroll
            for (int i = 0; i < 8; ++i) { v[i] = *(const u32x2*)(base + (size_t)(c0 + i) * 32 * 8192); d[i] = __hip_atomic_load(dc + (c0 + i) * 32, __ATOMIC_RELAXED, __HIP_MEMORY_SCOPE_AGENT); }
#pragma unroll
            for (int i = 0; i < 8; ++i) { u32x2 o; o.x = cvtpk(hs[0], hs[1]); o.y = cvtpk(hs[2], hs[3]); *(u32x2*)(base + (size_t)(c0 + i) * 32 * 8192) = o;
                hs[0] = d[i] * hs[0] + __uint_as_float(v[i].x << 16); hs[1] = d[i] * hs[1] + __uint_as_float(v[i].x & 0xffff0000u);
                hs[2] = d[i] * hs[2] + __uint_as_float(v[i].y << 16); hs[3] = d[i] * hs[3] + __uint_as_float(v[i].y & 0xffff0000u); }
        }
    }
}

__device__ __forceinline__ void s4_phase(lptr lds, int vcu, int G, const bf16_t* xbc, const float* dt, const float* acl, const float* tot,
                                         const bf16_t* st0, const bf16_t* st1, const float* dskip, const float* normw, bf16_t* zy) {
    const int tid = threadIdx.x, lane = tid & 63, r32 = lane & 31, hi = lane >> 5; const int wid = __builtin_amdgcn_readfirstlane(tid >> 6);
    const unsigned lds0 = (unsigned)(uintptr_t)lds;
    const unsigned vx = (unsigned)(((lane >> 2) * XBC + 8 * (lane & 3)) * 2);
    __attribute__((address_space(3))) float* ssh = (__attribute__((address_space(3))) float*)(lds + TAB_SS);
    __attribute__((address_space(3))) float* nwt = (__attribute__((address_space(3))) float*)(lds + TAB_NW);
    SSD_LF ac = (SSD_LF)(lds + TAB_AC); SSD_LF dtt = (SSD_LF)(lds + TAB_DT);
    const int k = wid >> 1, lh = wid & 1;
    const int lanepat = (4 * hi + ((lane & 15) >> 2)) * 64 + ((lane >> 4) & 1) * 32 + (lane & 3) * 8;
    const int swt = 16 * (hi ^ (r32 & 15));
#define S4_DMA_X(uu) do { const int b_ = (uu) >> 9, c_ = ((uu) >> 3) & 63, g_ = (uu) & 7; const char* xg_ = (const char*)(xbc + (size_t)(b_ * SEQ + c_ * L) * XBC + 256 * g_); \
        _Pragma("unroll") for (int i_ = 0; i_ < 8; ++i_) { const int pi_ = wid * 8 + i_, blk_ = pi_ >> 3, rgp_ = pi_ & 7; \
            glds16s(xg_ + (size_t)(16 * rgp_) * XBC * 2 + 64 * blk_, vx, (unsigned)__builtin_amdgcn_readfirstlane(lds0 + IMG_X + blk_ * 8192 + rgp_ * 1024)); } } while (0)
    int u = vcu; if (u >= 1024) return;
    S4_DMA_X(u);
    for (; u < 1024; u += G) {
        const int b = u >> 9, c = (u >> 3) & 63, g = u & 7, h = 4 * g + k;
        const int row0 = b * SEQ + c * L; const bf16_t* xrow = xbc + (size_t)row0 * XBC;
        { const char* bg = (const char*)(xrow + 2048 + 128 * g);
#pragma unroll
          for (int i = 0; i < 4; ++i) { const int pi = wid * 4 + i; const int prow = 4 * pi + (lane >> 4);
              const unsigned vb = (unsigned)((prow * XBC + 8 * ((lane & 15) ^ (prow & 15))) * 2);
              glds16s(bg, vb, (unsigned)__builtin_amdgcn_readfirstlane(lds0 + IMG_B + pi * 1024));
              glds16s(bg + 2048, vb, (unsigned)__builtin_amdgcn_readfirstlane(lds0 + IMG_C + pi * 1024)); } }
        { int tid_ = tid; asm volatile("" : "+v"(tid_));
          tables_load(lds, dt, acl, tot, row0, g, tid_);
          if (tid_ < 256) nwt[tid_] = normw[256 * g + tid_]; }
        SSD_BAR();
        const bf16_t* prev = (b == 0 ? st0 : st1) + ((size_t)c * 32 + h) * 8192;
        f32x16 yT[2][2];
#pragma unroll
        for (int lt = 0; lt < 2; ++lt) {
            const int Lt = lt == 0 ? lh : 3 - lh; const int l = 32 * Lt + r32; const float acl_ = ac[k * 128 + l];
            yT[lt][0] = f32x16{}; yT[lt][1] = f32x16{};
#define SSD_CF(ks) (*(const __attribute__((address_space(3))) bf16x8*)(lds + ((IMG_C + l * 256 + swt) ^ ((ks) * 32))))
            for (int st = 0; st <= Lt; ++st) {
                f32x16 cbt = f32x16{};
#pragma unroll
                for (int ks = 0; ks < 8; ++ks) { const bf16x8 bfr = *(const __attribute__((address_space(3))) bf16x8*)(lds + ((IMG_B + (32 * st + r32) * 256 + swt) ^ (ks * 32)));
                    cbt = __builtin_amdgcn_mfma_f32_32x32x16_bf16(bfr, SSD_CF(ks), cbt, 0, 0, 0); }
#pragma unroll
                for (int rq = 0; rq < 4; ++rq) { const int s0 = 32 * st + 8 * rq + 4 * hi;
                    const f32x4 as = *(const __attribute__((address_space(3))) f32x4*)(ac + k * 128 + s0), ds = *(const __attribute__((address_space(3))) f32x4*)(dtt + k * 128 + s0);
#pragma unroll
                    for (int j = 0; j < 4; ++j) { float w = cbt[4 * rq + j] * __builtin_amdgcn_exp2f(acl_ - as[j]) * ds[j]; if (s0 + j > l) w = 0.f; cbt[4 * rq + j] = w; } }
                bf16x8 wb[2];
#pragma unroll
                for (int sp = 0; sp < 2; ++sp) { u32x4 pk; pk.x = cvtpk(cbt[8 * sp], cbt[8 * sp + 1]); pk.y = cvtpk(cbt[8 * sp + 2], cbt[8 * sp + 3]); pk.z = cvtpk(cbt[8 * sp + 4], cbt[8 * sp + 5]); pk.w = cvtpk(cbt[8 * sp + 6], cbt[8 * sp + 7]); wb[sp] = __builtin_bit_cast(bf16x8, pk); }
#pragma unroll
                for (int pt = 0; pt < 2; ++pt)
#pragma unroll
                    for (int sp = 0; sp < 2; ++sp) { const lptr pa = lds + IMG_X + (2 * k + pt) * 8192 + (32 * st + 16 * sp) * 64 + lanepat; const s16x4 lo = vtr(pa), hh = vtr(pa + 512);
                        const bf16x8 xf = (bf16x8){lo[0], lo[1], lo[2], lo[3], hh[0], hh[1], hh[2], hh[3]};
                        yT[lt][pt] = __builtin_amdgcn_mfma_f32_32x32x16_bf16(xf, wb[sp], yT[lt][pt], 0, 0, 0); }
            }
            const float eal = __builtin_amdgcn_exp2f(acl_);
#pragma unroll
            for (int pt = 0; pt < 2; ++pt) { f32x16 t = f32x16{};
#pragma unroll
                for (int kh = 0; kh < 2; ++kh) { bf16x8 pf[4];
#pragma unroll
                    for (int ks = 0; ks < 4; ++ks) pf[ks] = *(const bf16x8*)(prev + (size_t)((pt * 8 + 4 * kh + ks) * 64 + lane) * 8);
#pragma unroll
                    for (int ks = 0; ks < 4; ++ks) t = __builtin_amdgcn_mfma_f32_32x32x16_bf16(pf[ks], SSD_CF(4 * kh + ks), t, 0, 0, 0); }
#pragma unroll
                for (int r = 0; r < 16; ++r) yT[lt][pt][r] += t[r] * eal; }
            const float dk = dskip[h];
#pragma unroll
            for (int pt = 0; pt < 2; ++pt)
#pragma unroll
                for (int rq = 0; rq < 4; ++rq) { const u32x2 xv = *(const __attribute__((address_space(3))) u32x2*)(lds + IMG_X + (2 * k + pt) * 8192 + l * 64 + (8 * rq + 4 * hi) * 2);
                    yT[lt][pt][4 * rq] += dk * __uint_as_float(xv.x << 16); yT[lt][pt][4 * rq + 1] += dk * __uint_as_float(xv.x & 0xffff0000u);
                    yT[lt][pt][4 * rq + 2] += dk * __uint_as_float(xv.y << 16); yT[lt][pt][4 * rq + 3] += dk * __uint_as_float(xv.y & 0xffff0000u); }
        }
#undef SSD_CF
#pragma unroll
        for (int lt = 0; lt < 2; ++lt) { const int l = 32 * (lt == 0 ? lh : 3 - lh) + r32; float ss = 0.f;
            const bf16_t* zrow = zy + (size_t)(row0 + l) * 2048 + 256 * g + 64 * k + 4 * hi;
#pragma unroll
            for (int pt = 0; pt < 2; ++pt) { u32x2 zv[4];
#pragma unroll
                for (int rq = 0; rq < 4; ++rq) zv[rq] = *(const u32x2*)(zrow + 32 * pt + 8 * rq);
#pragma unroll
                for (int rq = 0; rq < 4; ++rq) {
                    float v0 = yT[lt][pt][4 * rq] * __uint_as_float(zv[rq].x << 16), v1 = yT[lt][pt][4 * rq + 1] * __uint_as_float(zv[rq].x & 0xffff0000u);
                    float v2 = yT[lt][pt][4 * rq + 2] * __uint_as_float(zv[rq].y << 16), v3 = yT[lt][pt][4 * rq + 3] * __uint_as_float(zv[rq].y & 0xffff0000u);
                    yT[lt][pt][4 * rq] = v0; yT[lt][pt][4 * rq + 1] = v1; yT[lt][pt][4 * rq + 2] = v2; yT[lt][pt][4 * rq + 3] = v3; ss += (v0 * v0 + v1 * v1) + (v2 * v2 + v3 * v3); } }
            ss += __shfl_xor(ss, 32);
            if (hi == 0) ssh[k * 128 + l] = ss; }
        SSD_BAR();
        if (u + G < 1024) S4_DMA_X(u + G);
#pragma unroll
        for (int lt = 0; lt < 2; ++lt) { const int l = 32 * (lt == 0 ? lh : 3 - lh) + r32;
            const float totq = (ssh[l] + ssh[128 + l]) + (ssh[256 + l] + ssh[384 + l]); const float rs = __builtin_amdgcn_rsqf(totq * (1.0f / 256.0f) + 1e-6f);
#pragma unroll
            for (int pt = 0; pt < 2; ++pt)
#pragma unroll
                for (int rq = 0; rq < 4; ++rq) { const int chn = 64 * k + 32 * pt + 8 * rq + 4 * hi; const f32x4 nw = *(const __attribute__((address_space(3))) f32x4*)(nwt + chn);
                    u32x2 o; o.x = cvtpk(yT[lt][pt][4 * rq] * rs * nw[0], yT[lt][pt][4 * rq + 1] * rs * nw[1]); o.y = cvtpk(yT[lt][pt][4 * rq + 2] * rs * nw[2], yT[lt][pt][4 * rq + 3] * rs * nw[3]);
                    *(__attribute__((address_space(3))) u32x2*)(lds + IMG_B + l * 512 + chn * 2) = o; } }
        asm volatile("s_waitcnt lgkmcnt(0)" ::: "memory"); __builtin_amdgcn_s_barrier(); asm volatile("" ::: "memory");
        { bf16_t* ydst = zy + (size_t)row0 * 2048 + 256 * g;
#pragma unroll
          for (int i = 0; i < 8; ++i) { const int idx = i * 512 + tid; const int r = idx >> 5, ch = idx & 31;
              st16_wt(ydst + (size_t)r * 2048 + ch * 8, *(const __attribute__((address_space(3))) u32x4*)(lds + IMG_B + r * 512 + ch * 16)); } }
        asm volatile("s_waitcnt lgkmcnt(0)" ::: "memory"); __builtin_amdgcn_s_barrier(); asm volatile("" ::: "memory");
    }
#undef S4_DMA_X
}
#undef SSD_LF
}

namespace misc {
typedef unsigned short bf16_t;
typedef float f32x4 __attribute__((ext_vector_type(4)));
typedef unsigned u32x4 __attribute__((ext_vector_type(4)));
typedef unsigned u32x2 __attribute__((ext_vector_type(2)));
typedef short bf16x8 __attribute__((ext_vector_type(8)));
typedef __attribute__((address_space(3))) unsigned char* lptr;
typedef __attribute__((address_space(3))) float* lfptr;
constexpr float LOG2E = 1.4426950408889634f;
__device__ __forceinline__ unsigned cvtpk(float lo, float hi) { unsigned r; asm volatile("v_cvt_pk_bf16_f32 %0, %1, %2" : "=v"(r) : "v"(lo), "v"(hi)); return r; }
#define MISC_BAR() do { asm volatile("s_waitcnt vmcnt(0) lgkmcnt(0)" ::: "memory"); __builtin_amdgcn_s_barrier(); asm volatile("" ::: "memory"); } while (0)

enum { MAP_ID = 0, MAP_CONV_IN = 1, MAP_FOX_IN = 2, MAP_GU = 3 };
template <int MAP> __device__ __forceinline__ int src_col32(int nb) {
    const int n = nb * 32;
    if (MAP == MAP_ID) return n;
    if (MAP == MAP_CONV_IN) { const int pn = n >> 8, t = n & 255; return pn < 8 ? ((t >> 7) ? 2048 : 1024) + 128 * pn + (t & 127) : 256 * (pn - 8) + t; }
    if (MAP == MAP_FOX_IN) { const int pn = n >> 8, t = n & 255; const int bj = t >> 7, wc = (t >> 5) & 3; return 256 * pn + 64 * wc + 32 * bj; }
      { const int pn = n >> 8, t = n & 255; return (t >> 7) * 2816 + 128 * pn + (t & 127); }
}
template <int MAP> struct TItem { f32x4 v[8]; bf16_t* dst; };
template <int MAP> __device__ __forceinline__ void titem_load(TItem<MAP>& T, const float* W, int K, int Nsrc, int Ndst, const float* nw, bf16_t* WT, int item, int lane) {
    const int nblk = Ndst / 32, kb = item / nblk, nb = item % nblk, k0 = 64 * kb, n0 = 32 * nb, s0 = src_col32<MAP>(nb); const int kg = lane >> 3, nc = lane & 7;
    const float* src = W + (size_t)(k0 + 8 * kg) * Nsrc + s0 + 4 * nc;
#pragma unroll
    for (int i = 0; i < 8; ++i) T.v[i] = __builtin_nontemporal_load((const f32x4*)(src + (size_t)i * Nsrc));
    if (nw) { const f32x4 w0 = *(const f32x4*)(nw + k0 + 8 * kg), w1 = *(const f32x4*)(nw + k0 + 8 * kg + 4);
#pragma unroll
        for (int i = 0; i < 4; ++i) { T.v[i] = T.v[i] * w0[i]; T.v[4 + i] = T.v[4 + i] * w1[i]; } }
    T.dst = WT + (size_t)(n0 + 4 * nc) * K + k0 + 8 * kg;
}
template <int MAP> __device__ __forceinline__ void titem_store(const TItem<MAP>& T, int K) {
#pragma unroll
    for (int j = 0; j < 4; ++j) { u32x4 o; o.x = cvtpk(T.v[0][j], T.v[1][j]); o.y = cvtpk(T.v[2][j], T.v[3][j]); o.z = cvtpk(T.v[4][j], T.v[5][j]); o.w = cvtpk(T.v[6][j], T.v[7][j]);
        st16_wt(T.dst + (size_t)j * K, o); }
}
template <int MAP> __device__ __forceinline__ void transpose_job(const float* W, int K, int Nsrc, int Ndst, const float* nw, bf16_t* WT, int gw, int NGW, int lane) {
    const int nitems = (K / 64) * (Ndst / 32);
    int it = gw;
    for (; it + 3 * NGW < nitems; it += 4 * NGW) { TItem<MAP> A, B, C, D;
        titem_load<MAP>(A, W, K, Nsrc, Ndst, nw, WT, it, lane); titem_load<MAP>(B, W, K, Nsrc, Ndst, nw, WT, it + NGW, lane);
        titem_load<MAP>(C, W, K, Nsrc, Ndst, nw, WT, it + 2 * NGW, lane); titem_load<MAP>(D, W, K, Nsrc, Ndst, nw, WT, it + 3 * NGW, lane);
        titem_store<MAP>(A, K); titem_store<MAP>(B, K); titem_store<MAP>(C, K); titem_store<MAP>(D, K); }
    for (; it < nitems; it += NGW) { TItem<MAP> A; titem_load<MAP>(A, W, K, Nsrc, Ndst, nw, WT, it, lane); titem_store<MAP>(A, K); }
}
__device__ __forceinline__ void gate_cols(const float* W, int Nsrc, int c0, int ncol, const float* nw, bf16_t* WT, int gtid, int gthreads) {
    for (int idx = gtid; idx < ncol * 1024; idx += gthreads) { const int n = idx >> 10, k = idx & 1023; const float v = W[(size_t)k * Nsrc + c0 + n] * nw[k];
        WT[idx] = (bf16_t)(cvtpk(v, v) & 0xffffu); }
}
__device__ __forceinline__ void row_pass2(const float* xrow, bf16_t* xbrow, float* ssqrow, int lane) {
    f32x4 v[2][4]; float s[2] = {0.f, 0.f};
#pragma unroll
    for (int r = 0; r < 2; ++r)
#pragma unroll
        for (int j = 0; j < 4; ++j) v[r][j] = __builtin_nontemporal_load((const f32x4*)(xrow + r * 1024) + lane + 64 * j);
#pragma unroll
    for (int r = 0; r < 2; ++r) {
#pragma unroll
        for (int j = 0; j < 4; ++j) { s[r] += (v[r][j][0] * v[r][j][0] + v[r][j][1] * v[r][j][1]) + (v[r][j][2] * v[r][j][2] + v[r][j][3] * v[r][j][3]);
            u32x2 w; w.x = cvtpk(v[r][j][0], v[r][j][1]); w.y = cvtpk(v[r][j][2], v[r][j][3]); ((u32x2*)(xbrow + r * 1024) + lane)[64 * j] = w; }
#pragma unroll
        for (int o = 1; o < 64; o <<= 1) s[r] += __shfl_xor(s[r], o);
    }
    if (lane < 8) ssqrow[lane] = (lane == 0) ? s[0] : (lane == 4) ? s[1] : 0.f;
}
template <int NC> __device__ __forceinline__ void mini_gemm(lptr lds, const bf16_t* xb, const bf16_t* wg, const float* ssq, int row0, int tid) {
    const int lane = tid & 63, wid = tid >> 6, r16 = lane & 15, kg = lane >> 4;
    f32x4 acc[4][NC / 16];
#pragma unroll
    for (int rb = 0; rb < 4; ++rb)
#pragma unroll
        for (int nb = 0; nb < NC / 16; ++nb) acc[rb][nb] = (f32x4){0.f, 0.f, 0.f, 0.f};
#pragma unroll
    for (int ks = 0; ks < 4; ++ks) { const int k0 = 128 * wid + 32 * ks + 8 * kg;
        bf16x8 bfr[NC / 16];
#pragma unroll
        for (int nb = 0; nb < NC / 16; ++nb) bfr[nb] = *(const bf16x8*)(wg + (size_t)(16 * nb + r16) * 1024 + k0);
#pragma unroll
        for (int rb = 0; rb < 4; ++rb) { const bf16x8 afr = *(const bf16x8*)(xb + (size_t)(row0 + 16 * rb + r16) * 1024 + k0);
#pragma unroll
            for (int nb = 0; nb < NC / 16; ++nb) acc[rb][nb] = __builtin_amdgcn_mfma_f32_16x16x32_bf16(afr, bfr[nb], acc[rb][nb], 0, 0, 0); } }
    lfptr part = (lfptr)lds + wid * 64 * NC;
#pragma unroll
    for (int rb = 0; rb < 4; ++rb)
#pragma unroll
        for (int nb = 0; nb < NC / 16; ++nb)
#pragma unroll
            for (int j = 0; j < 4; ++j) part[(16 * rb + 4 * kg + j) * NC + 16 * nb + r16] = acc[rb][nb][j];
    MISC_BAR();
    lfptr red = (lfptr)lds + 8 * 64 * NC;
    for (int idx = tid; idx < 64 * NC; idx += 512) { float s = 0.f;
#pragma unroll
        for (int w = 0; w < 8; ++w) s += ((lfptr)lds)[w * 64 * NC + idx];
        const int row = row0 + idx / NC; const f32x4 a = *(const f32x4*)(ssq + (size_t)row * 4);
        const float t = (a[0] + a[1]) + (a[2] + a[3]);
        red[idx] = s * __builtin_amdgcn_rsqf(t * (1.0f / 1024.0f) + 1e-6f); }
    MISC_BAR();
}
__device__ __forceinline__ void fox_gate_task(lptr lds, const bf16_t* xb, const bf16_t* wg, const float* ssq, const float* b_f, bf16_t* kx, float* gt, float* tl, int task, int tid) {
    const int row0 = task * 64; mini_gemm<16>(lds, xb, wg, ssq, row0, tid);
    const lfptr red = (lfptr)lds + 8 * 64 * 16; const int lane = tid & 63, wid = tid >> 6; const int b = row0 >> 13, tile = (row0 & 8191) >> 6;
#pragma unroll
    for (int hh = 0; hh < 2; ++hh) { const int h = 2 * wid + hh; const float xg = red[lane * 16 + h] + b_f[h];
        const float lf2 = -(fmaxf(-xg, 0.f) * LOG2E + __builtin_amdgcn_logf(1.0f + __builtin_amdgcn_exp2f(-fabsf(xg) * LOG2E)));
        float p = lf2;
#pragma unroll
        for (int o = 1; o < 64; o <<= 1) { const float t = __shfl_up(p, o); if (lane >= o) p += t; }
        const float tot = __shfl(p, 63); const float bias = tot - p;
        const unsigned h1 = cvtpk(bias, bias) & 0xffffu; const float r1 = bias - __uint_as_float(h1 << 16);
        const unsigned h2 = cvtpk(r1, r1) & 0xffffu; const float r2 = r1 - __uint_as_float(h2 << 16);
        const unsigned h3 = cvtpk(r2, r2) & 0xffffu;
        const int bh = b * 16 + h; u32x4 o; o.x = h1 | (h2 << 16); o.y = h3 | (0x3F80u << 16); o.z = 0x3F803F80u; o.w = 0u;
        *(u32x4*)(kx + ((size_t)bh * 8192 + (row0 & 8191) + lane) * 8) = o;
        if (lane == 0) { gt[bh * 128 + tile] = __builtin_amdgcn_exp2f(tot); tl[bh * 128 + tile] = tot; } }
    MISC_BAR();
}
__device__ __forceinline__ void ssd_dt_task(lptr lds, const bf16_t* xb, const bf16_t* wg, const float* ssq, const float* dt_bias, const float* a_log, float* dt, float* acl, float* tot, int task, int tid) {
    const int row0 = task * 64; mini_gemm<32>(lds, xb, wg, ssq, row0, tid);
    const lfptr red = (lfptr)lds + 8 * 64 * 32; const int lane = tid & 63, wid = tid >> 6;
#pragma unroll
    for (int hh = 0; hh < 4; ++hh) { const int h = 4 * wid + hh; const float xg = red[lane * 32 + h] + dt_bias[h];
        const float sp = fmaxf(xg, 0.f) + 0.6931471805599453f * __builtin_amdgcn_logf(1.0f + __builtin_amdgcn_exp2f(-fabsf(xg) * LOG2E));
        float p = sp * (-__builtin_amdgcn_exp2f(LOG2E * a_log[h])) * LOG2E;
#pragma unroll
        for (int o = 1; o < 64; o <<= 1) { const float t = __shfl_up(p, o); if (lane >= o) p += t; }
        dt[(size_t)(row0 + lane) * 32 + h] = sp; acl[(size_t)(row0 + lane) * 32 + h] = p;
        if (lane == 63) tot[(size_t)task * 32 + h] = p; }
    MISC_BAR();
}
}

#define GAS __attribute__((address_space(1)))
#define LAS __attribute__((address_space(3)))
typedef unsigned short bf16;
typedef unsigned v4u __attribute__((ext_vector_type(4)));
typedef float f32x4 __attribute__((ext_vector_type(4)));
typedef short bf16x8 __attribute__((ext_vector_type(8)));
typedef GAS unsigned gu32;
typedef GAS unsigned long long gu64;
#define RLX_AGENT __ATOMIC_RELAXED, __HIP_MEMORY_SCOPE_AGENT
#define LDS_WAIT() asm volatile("s_waitcnt lgkmcnt(0)" ::: "memory")
#define VM_WAIT() asm volatile("s_waitcnt vmcnt(0)" ::: "memory")
__device__ __forceinline__ unsigned long long rt() { return __builtin_amdgcn_s_memrealtime(); }
__device__ __forceinline__ unsigned f2bf(float f) { unsigned u = __builtin_bit_cast(unsigned, f); return (u + 0x7fffu + ((u >> 16) & 1u)) >> 16; }
__device__ __forceinline__ unsigned pk2(float lo, float hi) { return f2bf(lo) | (f2bf(hi) << 16); }

#define XB_TMO      128
#define XB_XCNT(j)  (256  + 64 * (j))
#define XB_XSUB(j)  (1280 + 64 * (j))
#define XB_XGEN(j)  (2304 + 64 * (j))
#define XB_TOP      3328
#define XB_TOPGEN   3392
#define XCD_BAR_WORDS 3456
#define XB_SPIN_CAP (1u << 18)

__device__ __forceinline__ unsigned xb_ld(unsigned* p)              { return __hip_atomic_load(p, __ATOMIC_RELAXED, __HIP_MEMORY_SCOPE_AGENT); }
__device__ __forceinline__ unsigned xb_add(unsigned* p, unsigned v) { return __hip_atomic_fetch_add(p, v, __ATOMIC_RELAXED, __HIP_MEMORY_SCOPE_AGENT); }
__device__ __forceinline__ unsigned xb_xcc_id() { return (unsigned)__builtin_amdgcn_s_getreg((3 << 11) | 20) & 0xFu; }
#define XB_SPIN(cond, bar) do { unsigned _sp = 0; while (cond) { __builtin_amdgcn_s_sleep(1); \
    if ((++_sp & 255u) == 0u) { if (xb_ld(&(bar)[XB_TMO])) break; if (_sp > XB_SPIN_CAP) { atomicAdd(&(bar)[XB_TMO], 1u); break; } } } } while (0)

struct XcdBarrier {
    unsigned* bar; unsigned x;
    volatile LAS unsigned* st;
};

__device__ __forceinline__ XcdBarrier xcd_barrier_post(unsigned* bar, volatile LAS unsigned* st) {
    XcdBarrier b; b.bar = bar; b.x = xb_xcc_id(); b.st = st;
    if (threadIdx.x == 0) (void)xb_add(&bar[XB_XCNT(b.x)], 1u);
    return b;
}
__device__ __forceinline__ void xcd_barrier_complete(unsigned* bar, unsigned x, unsigned& nloc, unsigned& nx) {
    const unsigned G = gridDim.x * gridDim.y * gridDim.z;
    unsigned sum, cnt, mine, sp = 0u;
    for (;;) {
        sum = 0u; cnt = 0u; mine = 0u;
#pragma unroll
        for (unsigned j = 0; j < 16; ++j) { const unsigned c = xb_ld(&bar[XB_XCNT(j)]); sum += c; cnt += (c > 0u) ? 1u : 0u; mine = (j == x) ? c : mine; }
        if (sum == G) break;
        __builtin_amdgcn_s_sleep(1);
        if ((++sp & 255u) == 0u) { if (xb_ld(&bar[XB_TMO])) break; if (sp > XB_SPIN_CAP) { atomicAdd(&bar[XB_TMO], 1u); break; } }
    }
    nloc = mine > 0u ? mine : 1u; nx = cnt > 0u ? cnt : 1u;
}

__device__ __forceinline__ void xcd_barrier(const XcdBarrier& b) {
    asm volatile("s_waitcnt vmcnt(0)" ::: "memory");
    __syncthreads();
    if (threadIdx.x == 0) {
        unsigned* bar = b.bar;
        __builtin_amdgcn_s_waitcnt(0);
        unsigned nloc = b.st[0], nx = b.st[1];
        if (nloc == 0u) { xcd_barrier_complete(bar, b.x, nloc, nx); b.st[0] = nloc; b.st[1] = nx; }
        const unsigned old = xb_add(&bar[XB_XSUB(b.x)], 1u);
        const unsigned gen = old / nloc;
        if (old + 1u == (gen + 1u) * nloc) {
            __builtin_amdgcn_fence(__ATOMIC_RELEASE, "agent");
            asm volatile("s_waitcnt vmcnt(0)" ::: "memory");
            asm volatile("buffer_inv sc1" ::: "memory");
            const unsigned og = xb_add(&bar[XB_TOP], 1u);
            const unsigned tg = og / nx;
            if (og + 1u == (tg + 1u) * nx) xb_add(&bar[XB_TOPGEN], 1u);
            else XB_SPIN(xb_ld(&bar[XB_TOPGEN]) == tg, bar);
            asm volatile("s_waitcnt vmcnt(0)" ::: "memory");
            xb_add(&bar[XB_XGEN(b.x)], 1u);
            asm volatile("s_waitcnt vmcnt(0)" ::: "memory");
        } else {
            asm volatile("buffer_inv sc1" ::: "memory");
            XB_SPIN(xb_ld(&bar[XB_XGEN(b.x)]) == gen, bar);
            asm volatile("s_waitcnt vmcnt(0)" ::: "memory");
        }
    }
    __syncthreads();
}

constexpr int NWAVES = 8;
#ifndef MK_N_LAUNCHES
#define MK_N_LAUNCHES 1
#endif
constexpr int M = 16384, DMODEL = 1024, FF = 2816, NGU = 5632, SEQ = 8192;
constexpr size_t MiB = 1u << 20;
constexpr size_t WS_CTL = 0, CTL_ZERO_BYTES = 64 * 1024;
constexpr size_t WS_W = 1 * MiB;
constexpr size_t SZ_CIN = (size_t)3072 * 1024 * 2, SZ_SQ = (size_t)1024 * 1024 * 2, SZ_GU = (size_t)NGU * 1024 * 2, SZ_DN = (size_t)1024 * FF * 2, SZ_SIN = (size_t)6144 * 1024 * 2, SZ_SOUT = (size_t)1024 * 2048 * 2;
constexpr size_t W_L0_IN = WS_W, W_L0_OUT = W_L0_IN + SZ_CIN, W_L0_GU = W_L0_OUT + SZ_SQ, W_L0_DN = W_L0_GU + SZ_GU;
constexpr size_t W_L1_IN = W_L0_DN + SZ_DN, W_L1_OUT = W_L1_IN + SZ_CIN, W_L1_GU = W_L1_OUT + SZ_SQ, W_L1_DN = W_L1_GU + SZ_GU;
constexpr size_t W_L2_IN = W_L1_DN + SZ_DN, W_L2_OUT = W_L2_IN + SZ_SIN, W_L2_GU = W_L2_OUT + SZ_SOUT, W_L2_DN = W_L2_GU + SZ_GU;
constexpr size_t W_L3_IN = W_L2_DN + SZ_DN, W_L3_OUT = W_L3_IN + SZ_CIN, W_L3_GU = W_L3_OUT + SZ_SQ, W_L3_DN = W_L3_GU + SZ_GU;
constexpr size_t W_END = W_L3_DN + SZ_DN;
static_assert(W_END <= 107 * MiB, "weights");
constexpr size_t WS_WGATE = 107 * MiB;
constexpr size_t WS_XB = 108 * MiB;
constexpr size_t WS_SSQ = 140 * MiB;
constexpr size_t WS_KX = 141 * MiB;
constexpr size_t WS_DT = 145 * MiB;
constexpr size_t WS_GT = 147 * MiB;
constexpr size_t WS_T = 148 * MiB;
constexpr size_t WS_H = WS_T;
constexpr size_t WS_CV = WS_T, WS_Y = WS_T + 32 * MiB;
constexpr size_t WS_Q = WS_T;
constexpr size_t WS_ZY = WS_T, WS_XBC = WS_T + 64 * MiB;
constexpr size_t WS_ST1 = WS_W;
constexpr size_t WS_HALO = WS_XBC + 128 * MiB;
constexpr size_t WS_ACL = WS_HALO + 4 * MiB, WS_TOT = WS_ACL + 2 * MiB;
constexpr size_t WS_END = WS_TOT + 1 * MiB;
static_assert(WS_ST1 + 32 * MiB <= W_L2_IN, "states of batch 1 must only cover dead weights");
static_assert(WS_END == 347 * MiB, "ws map");
constexpr int CW_FLAG = 16;
constexpr int CW_BAR = 1024;
constexpr int RING_OFF = 0, RING_BYTES = 131072;
constexpr int LDSCTL_OFF = 146432, MISC_OFF = LDSCTL_OFF + 320;
constexpr int LDS_BYTES = 147456;
static_assert(attn::LDS_BYTES <= RING_BYTES && ssd::TAB_MISC + 64 <= LDSCTL_OFF, "LDS map");

struct Args { const float* in[21]; float* out; unsigned char* ws; int ph_lo, ph_hi; };
enum { PH_PRO = 0, PH_L0_IN, PH_L0_MIX, PH_L0_OUT, PH_L0_GU, PH_L0_DN,
       PH_L1_IN, PH_L1_ATT, PH_L1_OUT, PH_L1_GU, PH_L1_DN,
       PH_L2_IN, PH_L2_S2, PH_L2_S3, PH_L2_S4, PH_L2_OUT, PH_L2_GU, PH_L2_DN,
       PH_L3_IN, PH_L3_MIX, PH_L3_OUT, PH_L3_GU, PH_L3_DN, PH_COUNT };

__global__ void __launch_bounds__(NWAVES * 64, 2) mega_fwd(Args args) {
    extern __shared__ __attribute__((aligned(16))) unsigned char lds[];
    LAS unsigned char* const L = (LAS unsigned char*)lds;
    const int tid = threadIdx.x, lane = tid & 63, wave = __builtin_amdgcn_readfirstlane(tid >> 6);
    const int G = gridDim.x; const int bx = blockIdx.x; const int vcu = (G % 8 == 0) ? (bx % 8) * (G / 8) + bx / 8 : bx;
    unsigned char* const ws = args.ws;
    gu32* const ctl = (gu32*)(ws + WS_CTL);
    for (int u = tid; u < (LDS_BYTES - LDSCTL_OFF) / 4; u += NWAVES * 64) ((LAS unsigned*)(L + LDSCTL_OFF))[u] = 0u;
    __syncthreads();
    XcdBarrier bar; bar.bar = (unsigned*)(ctl + CW_BAR); bar.x = 0; bar.st = nullptr;
    if (MK_N_LAUNCHES == 1) bar = xcd_barrier_post((unsigned*)(ctl + CW_BAR), (volatile LAS unsigned*)(L + MISC_OFF) + 8);
    const int lo = args.ph_lo, hi = args.ph_hi;
#define IN(k) (lo <= (k) && (k) < hi)
#ifndef PROBE_MASK
#define PROBE_MASK 0ull
#endif
#ifndef PROBE_MULT
#define PROBE_MULT 1ull
#endif
#ifndef PROBE_SKEW
#define PROBE_SKEW 0ull
#define PROBE_SKEWSTAT 0
#endif
    unsigned long long pr_seg = 0; unsigned long long pr_t0 = 0, pr_acc = 0;
    if (PROBE_MASK != 0ull) pr_t0 = __builtin_amdgcn_s_memrealtime();
#define SEAM(k) do { if (IN(k) && IN((k) + 1)) { unsigned long long bt0_ = 0; if (PROBE_SEG == 7) bt0_ = __builtin_amdgcn_s_memrealtime(); if (PROBE_SEG == 8 && tid == 0) ((unsigned long long*)(ws + WS_END))[(k) * 256 + bx] = __builtin_amdgcn_s_memrealtime(); xcd_barrier(bar); if (PROBE_SEG == 7) pr_seg += __builtin_amdgcn_s_memrealtime() - bt0_; } \
    if (PROBE_MASK != 0ull) { const unsigned long long now_ = __builtin_amdgcn_s_memrealtime(); if ((PROBE_MASK >> (k)) & 1ull) pr_acc += now_ - pr_t0; pr_t0 = now_; } } while (0)
    typedef pg8::bf16_t bf16_t;
    float* const X = args.out;
    bf16_t* const XB = (bf16_t*)(ws + WS_XB); float* const SSQ = (float*)(ws + WS_SSQ);
    const float* const mix_norm = args.in[1]; const float* const ffn_norm = args.in[2];

#define RUN_JOB(Wp, K_, NS_, ND_, MAP_, NWp, DST_, GW_, NGW_) misc::transpose_job<MAP_>((Wp), (K_), (NS_), (ND_), (NWp), (bf16_t*)(ws + (DST_)), (GW_), (NGW_), lane)
#define CONVERT_LAYERS(LMASK_, GW_, NGW_) do { \
        for (int i_ = 0; i_ < 4; ++i_) if (((LMASK_) >> i_) & 1) { \
            const size_t gu_dst = (i_ == 0 ? W_L0_GU : i_ == 1 ? W_L1_GU : i_ == 2 ? W_L2_GU : W_L3_GU), dn_dst = (i_ == 0 ? W_L0_DN : i_ == 1 ? W_L1_DN : i_ == 2 ? W_L2_DN : W_L3_DN); \
            RUN_JOB(args.in[3] + (size_t)i_ * 1024 * NGU, 1024, NGU, NGU, misc::MAP_GU, ffn_norm + i_ * 1024, gu_dst, GW_, NGW_); \
            RUN_JOB(args.in[4] + (size_t)i_ * FF * 1024, FF, 1024, 1024, misc::MAP_ID, (const float*)nullptr, dn_dst, GW_, NGW_); \
            if (i_ == 0 || i_ == 3) { const int j_ = i_ == 0 ? 0 : 1; \
                RUN_JOB(args.in[5] + (size_t)j_ * 1024 * 3072, 1024, 3072, 3072, misc::MAP_CONV_IN, mix_norm + i_ * 1024, (j_ == 0 ? W_L0_IN : W_L3_IN), GW_, NGW_); \
                RUN_JOB(args.in[7] + (size_t)j_ * 1024 * 1024, 1024, 1024, 1024, misc::MAP_ID, (const float*)nullptr, (j_ == 0 ? W_L0_OUT : W_L3_OUT), GW_, NGW_); } \
            if (i_ == 1) { RUN_JOB(args.in[8], 1024, 3088, 3072, misc::MAP_FOX_IN, mix_norm + 1024, W_L1_IN, GW_, NGW_); RUN_JOB(args.in[12], 1024, 1024, 1024, misc::MAP_ID, (const float*)nullptr, W_L1_OUT, GW_, NGW_); } \
            if (i_ == 2) { RUN_JOB(args.in[13], 1024, 6176, 6144, misc::MAP_ID, mix_norm + 2048, W_L2_IN, GW_, NGW_); RUN_JOB(args.in[20], 2048, 1024, 1024, misc::MAP_ID, (const float*)nullptr, W_L2_OUT, GW_, NGW_); } } } while (0)
    const bool late_convert = (G == 256);
    if (IN(PH_PRO)) {
        const int gw = vcu * NWAVES + wave, NGW = G * NWAVES;
        CONVERT_LAYERS((late_convert ? 1 : 15), gw, NGW);
        misc::gate_cols(args.in[8], 3088, 3072, 16, mix_norm + 1024, (bf16_t*)(ws + WS_WGATE), vcu * 512 + tid, G * 512);
        misc::gate_cols(args.in[13], 6176, 6144, 32, mix_norm + 2048, (bf16_t*)(ws + WS_WGATE + 65536), vcu * 512 + tid, G * 512);
        for (int m = 2 * gw; m < M; m += 2 * NGW) misc::row_pass2(args.in[0] + (size_t)m * 1024, XB + (size_t)m * 1024, SSQ + (size_t)m * 4, lane);
        asm volatile("s_waitcnt vmcnt(0) lgkmcnt(0)" ::: "memory"); __syncthreads();
    }
    SEAM(PH_PRO);

#define FFN_PHASES(PH_GU_, PH_DN_, WGU_, WDN_, RMODE_, NEXTL_) do { \
    if (IN(PH_GU_)) { pg8::Gemm g{XB, (const bf16_t*)(ws + (WGU_)), M, NGU, 1024}; pg8::StaticOrder S; S.init(M, NGU, G, bx); \
        pg8::EpiGU E{(bf16_t*)(ws + WS_H), SSQ}; pg8::gemm_phase<pg8::EpiGU, pg8::StaticOrder, true, true>(L + RING_OFF, g, S, E); \
        if (late_convert && (NEXTL_) < 4 && bx >= 128) { CONVERT_LAYERS((1 << (NEXTL_)), (bx - 128) * NWAVES + wave, 128 * NWAVES); } } \
    SEAM(PH_GU_); \
    if (IN(PH_DN_)) { pg8::Gemm g{(const bf16_t*)(ws + WS_H), (const bf16_t*)(ws + (WDN_)), M, 1024, FF}; pg8::StaticOrder S; S.init(M, 1024, G, bx); \
        pg8::EpiResid<RMODE_> E{nullptr, X, XB, SSQ, (LAS float*)(L + 131072)}; pg8::gemm_phase<pg8::EpiResid<RMODE_>, pg8::StaticOrder, true, true>(L + RING_OFF, g, S, E); } \
    SEAM(PH_DN_); } while (0)
#define CONV_LAYER(PH_IN_, PH_MIX_, PH_OUT_, WIN_, WOUT_, J_, RMODE_) do { \
    if (IN(PH_IN_)) { pg8::Gemm g{XB, (const bf16_t*)(ws + (WIN_)), M, 2048, 1024}; pg8::StaticOrder S; S.init(M, 2048, G, bx);             \
        pg8::EpiConvIn E{(bf16_t*)(ws + WS_CV), SSQ}; pg8::gemm_phase<pg8::EpiConvIn, pg8::StaticOrder, true, true>(L + RING_OFF, g, S, E); } \
    SEAM(PH_IN_); \
    if (IN(PH_MIX_)) { pg8::Gemm g{XB, (const bf16_t*)(ws + (WIN_)) + (size_t)2048 * 1024, M, 1024, 1024}; pg8::StaticOrder S; S.init(M, 1024, G, bx);     \
        pg8::EpiConvB E{(const bf16_t*)(ws + WS_CV), (bf16_t*)(ws + WS_Y), SSQ, args.in[6] + (J_) * 3 * 1024, (LAS float*)(L + 131072)}; pg8::gemm_phase<pg8::EpiConvB, pg8::StaticOrder, true, true>(L + RING_OFF, g, S, E); } \
    SEAM(PH_MIX_); \
    if (IN(PH_OUT_)) { pg8::Gemm g{(const bf16_t*)(ws + WS_Y), (const bf16_t*)(ws + (WOUT_)), M, 1024, 1024}; pg8::StaticOrder S; S.init(M, 1024, G, bx); \
        pg8::EpiResid<RMODE_> E{args.in[0], X, XB, SSQ, (LAS float*)(L + 131072)}; pg8::gemm_phase<pg8::EpiResid<RMODE_>, pg8::StaticOrder, true, true>(L + RING_OFF, g, S, E); } \
    SEAM(PH_OUT_); } while (0)

    CONV_LAYER(PH_L0_IN, PH_L0_MIX, PH_L0_OUT, W_L0_IN, W_L0_OUT, 0, 0);
    FFN_PHASES(PH_L0_GU, PH_L0_DN, W_L0_GU, W_L0_DN, 1, 1);

    if (IN(PH_L1_IN)) {
        pg8::Gemm g{XB, (const bf16_t*)(ws + W_L1_IN), M, 3072, 1024}; pg8::StaticOrder S; S.init(M, 3072, G, bx);
        pg8::EpiFoxIn E{(bf16_t*)(ws + WS_Q), SSQ, args.in[10], args.in[11], 0.125f * 1.4426950408889634f};
        pg8::gemm_phase<pg8::EpiFoxIn, pg8::StaticOrder, true, true>(L + RING_OFF, g, S, E);
        for (int task = vcu; task < M / 64; task += G)
            misc::fox_gate_task((misc::lptr)(L + RING_OFF), XB, (const bf16_t*)(ws + WS_WGATE), SSQ, args.in[9], (bf16_t*)(ws + WS_KX), (float*)(ws + WS_GT), (float*)(ws + WS_GT + 65536), task, tid);
    }
    SEAM(PH_L1_IN);
    if (IN(PH_L1_ATT)) {
        float limit;
        { float gq = fabsf(args.in[10][lane]), gk = fabsf(args.in[11][lane]);
#pragma unroll
          for (int o = 1; o < 64; o <<= 1) { gq = fmaxf(gq, __shfl_xor(gq, o)); gk = fmaxf(gk, __shfl_xor(gk, o)); }
          limit = 45.0f + 2.05f * (8.0f * 1.4426950408889634f) * gq * gk; }
        const float* TL = (const float*)(ws + WS_GT + 65536);
        LAS float* hc = (LAS float*)(L + 131072); LAS int* hperm = (LAS int*)(L + 131072 + 128);
        if (G == 256) {
#pragma unroll
            for (int k = 0; k < 4; ++k) { const int h = 4 * wave + k; float v = TL[h * 128 + lane] + TL[h * 128 + 64 + lane];
#pragma unroll
                for (int o = 1; o < 64; o <<= 1) v += __shfl_xor(v, o);
                if (lane == 0) hc[h] = v; }
            __syncthreads();
            if (tid < 32) { const float my = hc[tid]; int rank = 0;
                for (int j = 0; j < 32; ++j) { const float o = hc[j]; rank += (o > my || (o == my && j < tid)) ? 1 : 0; }
                hperm[rank] = tid; }
            __syncthreads();
        }
        for (int i = 0; i < 4; ++i) {
            int qb, bh;
            if (G == 256) { qb = (vcu >> 5) + 8 * i; const int c = vcu & 31; const int rk = (i == 0) ? c : (i == 1) ? 31 - ((c + 16) & 31) : (i == 2) ? ((c + 16) & 31) : 31 - c;
                            bh = __builtin_amdgcn_readfirstlane(hperm[rk]) & 31; }
            else { const int u = vcu + i * G; if (u >= 1024) break; qb = u >> 5; bh = u & 31; }
            const int tf = attn::first_tile(TL + bh * 128, qb, limit, lane);
            attn::attn_unit(bh >> 4, bh & 15, qb, tf, (const bf16_t*)(ws + WS_Q), (const bf16_t*)(ws + WS_Q + 32 * MiB), (const bf16_t*)(ws + WS_Q + 64 * MiB), (bf16_t*)(ws + WS_Q),
                            (const bf16_t*)(ws + WS_KX), (const float*)(ws + WS_GT + 65536), (char*)lds + RING_OFF);
        }
        asm volatile("s_waitcnt vmcnt(0)" ::: "memory"); __syncthreads();
    }
    SEAM(PH_L1_ATT);
    if (IN(PH_L1_OUT)) { pg8::Gemm g{(const bf16_t*)(ws + WS_Q), (const bf16_t*)(ws + W_L1_OUT), M, 1024, 1024}; pg8::StaticOrder S; S.init(M, 1024, G, bx);
        pg8::EpiResid<1> E{nullptr, X, XB, SSQ, (LAS float*)(L + 131072)}; pg8::gemm_phase<pg8::EpiResid<1>, pg8::StaticOrder, true, true>(L + RING_OFF, g, S, E); }
    SEAM(PH_L1_OUT);
    FFN_PHASES(PH_L1_GU, PH_L1_DN, W_L1_GU, W_L1_DN, 1, 2);

    if (IN(PH_L2_IN)) {
        pg8::Gemm g{XB, (const bf16_t*)(ws + W_L2_IN), M, 6144, 1024}; pg8::StaticOrder S; S.init(M, 6144, G, bx);
        pg8::EpiSsdIn E{(bf16_t*)(ws + WS_ZY), (bf16_t*)(ws + WS_XBC), SSQ, (bf16_t*)(ws + WS_HALO)};
        pg8::gemm_phase<pg8::EpiSsdIn, pg8::StaticOrder, true, true>(L + RING_OFF, g, S, E);
        for (int task = vcu; task < M / 64; task += G)
            misc::ssd_dt_task((misc::lptr)(L + RING_OFF), XB, (const bf16_t*)(ws + WS_WGATE + 65536), SSQ, args.in[16], args.in[17], (float*)(ws + WS_DT), (float*)(ws + WS_ACL), (float*)(ws + WS_TOT), task, tid);
    }
    SEAM(PH_L2_IN);
    if (IN(PH_L2_S2)) {
        for (int u = vcu; u < 1024; u += G) { const int b = u >> 9, c = (u >> 3) & 63, g = u & 7;
            ssd::s2_unit((ssd::lptr)(L + RING_OFF), b, c, g, (bf16_t*)(ws + WS_XBC), (const bf16_t*)(ws + WS_HALO), (const float*)(ws + WS_DT), (const float*)(ws + WS_ACL), (const float*)(ws + WS_TOT), args.in[14], args.in[15],
                         (b == 0 ? (bf16_t*)X : (bf16_t*)(ws + WS_ST1)), (float*)(ws + WS_GT + 131072)); }
        asm volatile("s_waitcnt vmcnt(0) lgkmcnt(0)" ::: "memory"); __syncthreads();
    }
    SEAM(PH_L2_S2);
    if (IN(PH_L2_S3)) { ssd::s3_scan((bf16_t*)X, (bf16_t*)(ws + WS_ST1), (const float*)(ws + WS_GT + 131072), vcu, G); asm volatile("s_waitcnt vmcnt(0)" ::: "memory"); __syncthreads(); }
    SEAM(PH_L2_S3);
    if (IN(PH_L2_S4)) {
        ssd::s4_phase((ssd::lptr)(L + RING_OFF), vcu, G, (const bf16_t*)(ws + WS_XBC), (const float*)(ws + WS_DT), (const float*)(ws + WS_ACL), (const float*)(ws + WS_TOT),
                      (const bf16_t*)X, (const bf16_t*)(ws + WS_ST1), args.in[18], args.in[19], (bf16_t*)(ws + WS_ZY));
    }
    SEAM(PH_L2_S4);
    if (IN(PH_L2_OUT)) { pg8::Gemm g{(const bf16_t*)(ws + WS_ZY), (const bf16_t*)(ws + W_L2_OUT), M, 1024, 2048}; pg8::StaticOrder S; S.init(M, 1024, G, bx);
        pg8::EpiResid<1> E{nullptr, X, XB, SSQ, (LAS float*)(L + 131072)}; pg8::gemm_phase<pg8::EpiResid<1>, pg8::StaticOrder, true, true>(L + RING_OFF, g, S, E); }
    SEAM(PH_L2_OUT);
    FFN_PHASES(PH_L2_GU, PH_L2_DN, W_L2_GU, W_L2_DN, 1, 3);

    CONV_LAYER(PH_L3_IN, PH_L3_MIX, PH_L3_OUT, W_L3_IN, W_L3_OUT, 1, 1);
    FFN_PHASES(PH_L3_GU, PH_L3_DN, W_L3_GU, W_L3_DN, 2, 4);
    if (PROBE_SEG == 8) {
        xcd_barrier(bar);
        if (bx == 0 && wave == 0) { unsigned long long acc_ = 0;
            for (int k = 0; k < PH_COUNT - 1; ++k) if ((PROBE_SKEW >> k) & 1ull) { unsigned long long mx = 0, mn = ~0ull, sm = 0;
                for (int j = 0; j < 4; ++j) { const unsigned long long v = __hip_atomic_load((unsigned long long*)(ws + WS_END) + k * 256 + lane + 64 * j, __ATOMIC_RELAXED, __HIP_MEMORY_SCOPE_AGENT); mx = v > mx ? v : mx; mn = v < mn ? v : mn; sm += v; }
                for (int o = 1; o < 64; o <<= 1) { const unsigned long long a = __shfl_xor(mx, o), b = __shfl_xor(mn, o), c = __shfl_xor(sm, o); mx = a > mx ? a : mx; mn = b < mn ? b : mn; sm += c; }
                acc_ += (PROBE_SKEWSTAT == 0) ? mx - sm / 256ull : mx - mn; }
            pr_seg = acc_; } }
    if ((PROBE_MASK != 0ull || PROBE_SEG != 0) && bx == 0 && tid == 0) { if (PROBE_SEG == 5 || PROBE_SEG == 6) pr_seg = *(LAS unsigned long long*)(L + LDSCTL_OFF + 64); const unsigned long long mult_ = (PROBE_SEG >= 5 && PROBE_SEG != 8) ? (PROBE_SEG == 7 ? 2ull : 1ull) : 4ull;
        const unsigned long long t0_ = __builtin_amdgcn_s_memrealtime(); while (__builtin_amdgcn_s_memrealtime() - t0_ < PROBE_MULT * pr_acc + mult_ * pr_seg) __builtin_amdgcn_s_sleep(8); }
#undef IN
#undef SEAM
}

extern "C" void kernel_launch(void* const* d_in, const int* in_sizes, int n_in, void* d_out, int out_size, void* d_ws, size_t ws_size, hipStream_t stream) {
    static int grid = 0;
    if (grid == 0) {
        if (n_in != 21 || in_sizes[0] != M * DMODEL || out_size != M * DMODEL || ws_size < WS_END) {
            fprintf(stderr, "kernel_launch: unexpected shapes (n_in %d, in0 %d, out %d, ws %zu < %zu); nothing launched\n", n_in, n_in > 0 ? in_sizes[0] : -1, out_size, ws_size, (size_t)WS_END); grid = -1; return; }
        int dev = 0, cus = 0, per_cu = 0;
        if (hipGetDevice(&dev) != hipSuccess || hipDeviceGetAttribute(&cus, hipDeviceAttributeMultiprocessorCount, dev) != hipSuccess) { grid = -1; return; }
        if (hipFuncSetAttribute((const void*)mega_fwd, hipFuncAttributeMaxDynamicSharedMemorySize, LDS_BYTES) != hipSuccess) { fprintf(stderr, "kernel_launch: hipFuncSetAttribute failed\n"); grid = -1; return; }
        if (hipOccupancyMaxActiveBlocksPerMultiprocessor(&per_cu, (const void*)mega_fwd, NWAVES * 64, LDS_BYTES) != hipSuccess || per_cu < 1)
            fprintf(stderr, "kernel_launch: note: occupancy query reports %d workgroups per CU\n", per_cu);
        (void)hipGetLastError();
        grid = cus;
    }
    if (grid < 0) return;
    (void)hipMemsetAsync((char*)d_ws + WS_CTL, 0, CTL_ZERO_BYTES, stream);
    Args a{};
    for (int i = 0; i < 21; ++i) a.in[i] = (const float*)d_in[i];
    a.out = (float*)d_out; a.ws = (unsigned char*)d_ws;
    if (MK_N_LAUNCHES == 1) { a.ph_lo = 0; a.ph_hi = PH_COUNT; hipLaunchKernelGGL(mega_fwd, dim3(grid), dim3(NWAVES * 64), LDS_BYTES, stream, a); }
    else for (int p = 0; p < PH_COUNT; ++p) { a.ph_lo = p; a.ph_hi = p + 1; hipLaunchKernelGGL(mega_fwd, dim3(grid), dim3(NWAVES * 64), LDS_BYTES, stream, a); }
}
```

```cpp
#include <hip/hip_runtime.h>
#include <hip/hip_bf16.h>
#include <cstdio>
#include <cstdint>
#include <cmath>
#include <type_traits>

#ifndef WT_STORES
#define WT_STORES 0
#endif
typedef unsigned wt_u32x4 __attribute__((ext_vector_type(4)));
__device__ __forceinline__ void st16_wt(void* p, wt_u32x4 v) {
#if WT_STORES
    asm volatile("global_store_dwordx4 %0, %1, off sc1\n\ts_nop 1" :: "v"(p), "v"(v) : "memory");
#else
    *(wt_u32x4*)p = v;
#endif
}

#ifndef PROBE_SEG
#define PROBE_SEG 0
#endif
#define SEG_T0(n) unsigned long long segt_##n = 0; if (PROBE_SEG == (n)) segt_##n = __builtin_amdgcn_s_memrealtime()
#define SEG_T1(n) do { if (PROBE_SEG == (n)) pr_seg += __builtin_amdgcn_s_memrealtime() - segt_##n; } while (0)
namespace pg8 {
#define PG8_LAS __attribute__((address_space(3)))
typedef unsigned short bf16_t;
typedef short bf16x8 __attribute__((ext_vector_type(8)));
typedef float f32x4 __attribute__((ext_vector_type(4)));
typedef unsigned u32x4 __attribute__((ext_vector_type(4)));
constexpr int BM = 256, BK = 64, HALF = 128, HTB = HALF * BK * 2  , STAGE_BYTES = 8 * HTB, NXCD = 8, WGM = 4;

__host__ __device__ __forceinline__ int lds_byte(int r, int c) { const int st = (r >> 4) * 2 + (c >> 5), rr = r & 15, cc = c & 31, ob = rr * 64 + cc * 2; return st * 1024 + (ob ^ (((ob >> 9) & 1) << 5)); }
__host__ __device__ __forceinline__ void stage_rc(int b, int& R, int& C) { const int st = b / 1024, sb = b % 1024, swz = sb ^ (((sb >> 9) & 1) << 5); R = (st >> 1) * 16 + swz / 64; C = (st & 1) * 32 + (swz % 64) / 2; }
__host__ __device__ __forceinline__ int perm32(int rho) { const int n = rho >> 4, i = rho & 15; return 8 * (i >> 2) + 4 * n + (i & 3); }

struct Unit { int pm, pn; };
struct Gemm { const bf16_t* A; const bf16_t* Bt; int M, N, K; };

struct StaticOrder {
    int nM, nN, nwg, G, c;
    __host__ __device__ void init(int M, int N, int G_, int c_) { nM = M / BM; nN = N / BM; nwg = nM * nN; G = G_; c = c_; }
    __host__ __device__ bool next(int i, Unit& u) const {
        const long L = (long)i * G + c; if (L >= nwg) return false;
        int wgid = (int)L; { const int q = nwg / NXCD, r = nwg % NXCD, xcd = wgid % NXCD, off = wgid / NXCD; wgid = (xcd < r ? xcd * (q + 1) : r * (q + 1) + (xcd - r) * q) + off; }
        const int nig = WGM * nN, gid = wgid / nig, fm = gid * WGM, gsz = (nM - fm) < WGM ? (nM - fm) : WGM;
        u.pm = fm + ((wgid % nig) % gsz); u.pn = (wgid % nig) / gsz; return true;
    }
    __device__ __forceinline__ void a_ready(const Unit&) const {}
    __device__ __forceinline__ void done(const Unit&) const {}
};


__device__ __forceinline__ unsigned cvt_pk_bf16(float lo, float hi) { unsigned r; asm volatile("v_cvt_pk_bf16_f32 %0, %1, %2" : "=v"(r) : "v"(lo), "v"(hi)); return r; }
__device__ __forceinline__ u32x4 pack8(const f32x4 a, const f32x4 b) { u32x4 w; w.x = cvt_pk_bf16(a[0], a[1]); w.y = cvt_pk_bf16(a[2], a[3]); w.z = cvt_pk_bf16(b[0], b[1]); w.w = cvt_pk_bf16(b[2], b[3]); return w; }
constexpr float RMS_EPS = 1e-6f;
constexpr float LOG2E = 1.4426950408889634f;
__device__ __forceinline__ void rstd8(const float* ssq, int row0, float (&rs)[8]) {
    f32x4 p[8];
#pragma unroll
    for (int i = 0; i < 8; ++i) p[i] = *(const f32x4*)(ssq + (size_t)(row0 + (i >> 2) * HALF + (i & 3) * 16) * 4);
#pragma unroll
    for (int i = 0; i < 8; ++i) rs[i] = __builtin_amdgcn_rsqf(((p[i][0] + p[i][1]) + (p[i][2] + p[i][3])) * (1.0f / 1024.0f) + RMS_EPS);
}
__device__ __forceinline__ float silu_f(float x) { return x * __builtin_amdgcn_rcpf(1.0f + __builtin_amdgcn_exp2f(-LOG2E * x)); }
__device__ __forceinline__ f32x4 silu4(f32x4 v) { f32x4 e = v * (-LOG2E);
    e[0] = __builtin_amdgcn_exp2f(e[0]); e[1] = __builtin_amdgcn_exp2f(e[1]); e[2] = __builtin_amdgcn_exp2f(e[2]); e[3] = __builtin_amdgcn_exp2f(e[3]); e = e + 1.0f;
    e[0] = __builtin_amdgcn_rcpf(e[0]); e[1] = __builtin_amdgcn_rcpf(e[1]); e[2] = __builtin_amdgcn_rcpf(e[2]); e[3] = __builtin_amdgcn_rcpf(e[3]); return v * e; }

struct EpiConvIn {
    static constexpr bool PERM = true, AFTER_DRAIN = false;
    bf16_t* cv; const float* ssq;
    __device__ __forceinline__ void operator()(const f32x4 (&acc)[2][2][4][2], const Unit& u, int wr, int wc, int fr, int fq) const {
        const int row0 = u.pm * BM + wr * 64 + fr; float rsv[8]; rstd8(ssq, row0, rsv);
#pragma unroll
        for (int ai = 0; ai < 2; ++ai)
#pragma unroll
            for (int m = 0; m < 4; ++m) { const int row = row0 + ai * HALF + m * 16; const float r2 = rsv[ai * 4 + m] * rsv[ai * 4 + m];
                const f32x4 v0 = acc[ai][0][m][0] * acc[ai][1][m][0] * r2, v1 = acc[ai][0][m][1] * acc[ai][1][m][1] * r2;
                st16_wt(cv + (size_t)row * 1024 + 128 * u.pn + 32 * wc + 8 * fq, pack8(v0, v1)); }
    }
};
struct EpiConvB {
    static constexpr bool PERM = true, AFTER_DRAIN = false;
    const bf16_t* cv; bf16_t* y; const float* ssq; const float* cw; PG8_LAS float* tab;
    __device__ __forceinline__ void operator()(const f32x4 (&acc)[2][2][4][2], const Unit& u, int wr, int wc, int fr, int fq) const {
        const int row0 = u.pm * BM + wr * 64 + fr; float rsv[8]; rstd8(ssq, row0, rsv);
        { const int t = threadIdx.x; if (t < 256) {
#pragma unroll
            for (int k = 0; k < 3; ++k) tab[k * 256 + t] = cw[k * 1024 + 256 * u.pn + t]; } }
        asm volatile("s_waitcnt vmcnt(0) lgkmcnt(0)" ::: "memory"); __builtin_amdgcn_s_barrier(); asm volatile("" ::: "memory");
#pragma unroll
        for (int bj = 0; bj < 2; ++bj) { const int tcol = 128 * bj + 32 * wc + 8 * fq, col = 256 * u.pn + tcol;
#pragma unroll
            for (int ah = 0; ah < 4; ++ah) { const int ai = ah >> 1, mb = (ah & 1) * 2;
                u32x4 raw[2][3];
#pragma unroll
                for (int mm = 0; mm < 2; ++mm) { const int row = row0 + ai * HALF + (mb + mm) * 16; const int t = row & 8191;
#pragma unroll
                    for (int k = 0; k < 3; ++k) raw[mm][k] = (t - 2 + k >= 0) ? *(const u32x4*)(cv + (size_t)(row - 2 + k) * 1024 + col) : (u32x4){0u, 0u, 0u, 0u}; }
#pragma unroll
                for (int mm = 0; mm < 2; ++mm) { const int m = mb + mm; const int row = row0 + ai * HALF + m * 16; const float rs = rsv[ai * 4 + m]; f32x4 o[2];
#pragma unroll
                    for (int n = 0; n < 2; ++n) { f32x4 a = (f32x4){0.f, 0.f, 0.f, 0.f};
#pragma unroll
                        for (int k = 0; k < 3; ++k) { const unsigned lo = n == 0 ? raw[mm][k].x : raw[mm][k].z, hi = n == 0 ? raw[mm][k].y : raw[mm][k].w;
                            const f32x4 xv = (f32x4){__uint_as_float(lo << 16), __uint_as_float(lo & 0xffff0000u), __uint_as_float(hi << 16), __uint_as_float(hi & 0xffff0000u)};
                            a = a + *(const PG8_LAS f32x4*)(tab + k * 256 + tcol + 4 * n) * xv; }
                        o[n] = a * (acc[ai][bj][m][n] * rs); }
                    st16_wt(y + (size_t)row * 1024 + col, pack8(o[0], o[1])); }
                asm volatile("" ::: "memory"); } }
        asm volatile("s_waitcnt lgkmcnt(0)" ::: "memory"); __builtin_amdgcn_s_barrier(); asm volatile("" ::: "memory");
    }
};
struct EpiFoxIn {
    static constexpr bool PERM = true, AFTER_DRAIN = false;
    bf16_t* qkv; const float* ssq; const float* qg; const float* kg; float qscale;
    __device__ __forceinline__ void operator()(const f32x4 (&acc)[2][2][4][2], const Unit& u, int wr, int wc, int fr, int fq) const {
        const int row0 = u.pm * BM + wr * 64 + fr; const int t = u.pn >> 2, head = 4 * (u.pn & 3) + wc; float rsv[8]; rstd8(ssq, row0, rsv);
        bf16_t* base = qkv + (size_t)t * ((size_t)16384 * 1024) + 64 * head + 8 * fq;
        f32x4 g[2][2];
#pragma unroll
        for (int bj = 0; bj < 2; ++bj)
#pragma unroll
            for (int n = 0; n < 2; ++n) { g[bj][n] = (f32x4){1.f, 1.f, 1.f, 1.f};
                if (t < 2) { g[bj][n] = *(const f32x4*)((t == 0 ? qg : kg) + 32 * bj + 8 * fq + 4 * n); if (t == 0) g[bj][n] = g[bj][n] * qscale; } }
#pragma unroll
        for (int ai = 0; ai < 2; ++ai)
#pragma unroll
            for (int m = 0; m < 4; ++m) { const int row = row0 + ai * HALF + m * 16; const float rs = rsv[ai * 4 + m];
                f32x4 v[2][2]; f32x4 sq = (f32x4){0.f, 0.f, 0.f, 0.f};
#pragma unroll
                for (int bj = 0; bj < 2; ++bj)
#pragma unroll
                    for (int n = 0; n < 2; ++n) { v[bj][n] = acc[ai][bj][m][n] * rs; sq = v[bj][n] * v[bj][n] + sq; }
                float ss = (sq[0] + sq[1]) + (sq[2] + sq[3]);
                if (t < 2) { ss += __shfl_xor(ss, 16); ss += __shfl_xor(ss, 32); const float hr = __builtin_amdgcn_rsqf(ss * (1.0f / 64.0f) + RMS_EPS);
#pragma unroll
                    for (int bj = 0; bj < 2; ++bj)
#pragma unroll
                        for (int n = 0; n < 2; ++n) v[bj][n] = v[bj][n] * g[bj][n] * hr; }
#pragma unroll
                for (int bj = 0; bj < 2; ++bj) st16_wt(base + (size_t)row * 1024 + 32 * bj, pack8(v[bj][0], v[bj][1])); }
    }
};
struct EpiSsdIn {
    static constexpr bool PERM = true, AFTER_DRAIN = false;
    bf16_t* zs; bf16_t* xbc; const float* ssq; bf16_t* halo;
    __device__ __forceinline__ void operator()(const f32x4 (&acc)[2][2][4][2], const Unit& u, int wr, int wc, int fr, int fq) const {
        const int row0 = u.pm * BM + wr * 64 + fr; float rsv[8]; rstd8(ssq, row0, rsv);
#pragma unroll
        for (int ai = 0; ai < 2; ++ai)
#pragma unroll
            for (int m = 0; m < 4; ++m) { const int row = row0 + ai * HALF + m * 16; const float rs = rsv[ai * 4 + m];
#pragma unroll
                for (int bj = 0; bj < 2; ++bj) { f32x4 v0 = acc[ai][bj][m][0] * rs, v1 = acc[ai][bj][m][1] * rs;
                    if (u.pn < 8) { v0 = silu4(v0); v1 = silu4(v1); st16_wt(zs + (size_t)row * 2048 + 256 * u.pn + 128 * bj + 32 * wc + 8 * fq, pack8(v0, v1)); }
                    else { const u32x4 pk = pack8(v0, v1); const int colx = 256 * (u.pn - 8) + 128 * bj + 32 * wc + 8 * fq; st16_wt(xbc + (size_t)row * 4096 + colx, pk);
                        if ((row & 127) >= 125) st16_wt(halo + ((size_t)((row >> 7) + 1) * 3 + ((row & 127) - 125)) * 4096 + colx, pk); } } }
    }
};
struct EpiGU {
    static constexpr bool PERM = true, AFTER_DRAIN = false;
    bf16_t* hb; const float* ssq;
    __device__ __forceinline__ void operator()(const f32x4 (&acc)[2][2][4][2], const Unit& u, int wr, int wc, int fr, int fq) const {
        const int row0 = u.pm * BM + wr * 64 + fr; float rsv[8]; rstd8(ssq, row0, rsv);
#pragma unroll
        for (int ai = 0; ai < 2; ++ai)
#pragma unroll
            for (int m = 0; m < 4; ++m) { const int row = row0 + ai * HALF + m * 16; const float rs = rsv[ai * 4 + m]; const float rs2 = rs * rs, nrs = -LOG2E * rs;
                f32x4 v[2];
#pragma unroll
                for (int n = 0; n < 2; ++n) { const f32x4 g = acc[ai][0][m][n]; const f32x4 gu = g * acc[ai][1][m][n]; f32x4 e = g * nrs;
                    e[0] = __builtin_amdgcn_exp2f(e[0]); e[1] = __builtin_amdgcn_exp2f(e[1]); e[2] = __builtin_amdgcn_exp2f(e[2]); e[3] = __builtin_amdgcn_exp2f(e[3]);
                    e = e + 1.0f;
                    e[0] = __builtin_amdgcn_rcpf(e[0]); e[1] = __builtin_amdgcn_rcpf(e[1]); e[2] = __builtin_amdgcn_rcpf(e[2]); e[3] = __builtin_amdgcn_rcpf(e[3]);
                    v[n] = (gu * rs2) * e; }
                st16_wt(hb + (size_t)row * 2816 + 128 * u.pn + 32 * wc + 8 * fq, pack8(v[0], v[1])); }
    }
};
template <int MODE> struct EpiResid {
    static constexpr bool PERM = true, AFTER_DRAIN = false;
    const float* xin; float* out; bf16_t* xb; float* ssq; PG8_LAS float* tab;
    __device__ __forceinline__ void operator()(const f32x4 (&acc)[2][2][4][2], const Unit& u, int wr, int wc, int fr, int fq) const {
        const int row0 = u.pm * BM + wr * 64 + fr; const int col0 = u.pn * BM + 32 * wc + 8 * fq;
#pragma unroll
        for (int ai = 0; ai < 2; ++ai) {
            f32x4 pre[4][2][2];
#pragma unroll
            for (int m = 0; m < 4; ++m) { const size_t ro = (size_t)(row0 + ai * HALF + m * 16) * 1024 + col0;
#pragma unroll
                for (int bj = 0; bj < 2; ++bj) {
                    if (MODE == 0) { pre[m][bj][0] = *(const f32x4*)(xin + ro + 128 * bj); pre[m][bj][1] = *(const f32x4*)(xin + ro + 128 * bj + 4); }
                    else { const u32x4 w = *(const u32x4*)(xb + ro + 128 * bj);
                        pre[m][bj][0] = (f32x4){__uint_as_float(w.x << 16), __uint_as_float(w.x & 0xffff0000u), __uint_as_float(w.y << 16), __uint_as_float(w.y & 0xffff0000u)};
                        pre[m][bj][1] = (f32x4){__uint_as_float(w.z << 16), __uint_as_float(w.z & 0xffff0000u), __uint_as_float(w.w << 16), __uint_as_float(w.w & 0xffff0000u)}; } } }
#pragma unroll
            for (int m = 0; m < 4; ++m) { const int row = row0 + ai * HALF + m * 16; const size_t ro = (size_t)row * 1024 + col0; f32x4 sq = (f32x4){0.f, 0.f, 0.f, 0.f};
#pragma unroll
                for (int bj = 0; bj < 2; ++bj) { const f32x4 a = pre[m][bj][0] + acc[ai][bj][m][0], b = pre[m][bj][1] + acc[ai][bj][m][1];
                    if (MODE == 2) { *(f32x4*)(out + ro + 128 * bj) = a; *(f32x4*)(out + ro + 128 * bj + 4) = b; }
                    else { sq = a * a + sq; sq = b * b + sq;
                        st16_wt(xb + ro + 128 * bj, pack8(a, b)); } }
                float ss = (sq[0] + sq[1]) + (sq[2] + sq[3]);
                if (MODE != 2) { ss += __shfl_xor(ss, 16); ss += __shfl_xor(ss, 32);
                    if (fq == 0) tab[wc * 256 + (row - u.pm * BM)] = ss; } }
            asm volatile("" ::: "memory"); }
        if (MODE != 2) {
        asm volatile("s_waitcnt lgkmcnt(0)" ::: "memory"); __builtin_amdgcn_s_barrier(); asm volatile("" ::: "memory");
        { const int t = threadIdx.x; if (t < 256) ssq[(size_t)(u.pm * BM + t) * 4 + u.pn] = (tab[t] + tab[256 + t]) + (tab[512 + t] + tab[768 + t]); }
        asm volatile("s_waitcnt lgkmcnt(0)" ::: "memory"); __builtin_amdgcn_s_barrier(); asm volatile("" ::: "memory");
        }
    }
};


template <class Epi, class Sched, bool ALIGN_EPI = false, bool SP2 = false>
__device__ __forceinline__ void gemm_phase(PG8_LAS unsigned char* lds, const Gemm g, const Sched& S, const Epi& E) {
    const int tid = threadIdx.x, wid = __builtin_amdgcn_readfirstlane(tid >> 6), lane = tid & 63, wr = wid >> 2, wc = wid & 3, fr = lane & 15, fq = lane >> 4;
    const int K = g.K, nt = K / BK;
    unsigned voffA[2], voffB[2];
#pragma unroll
    for (int i = 0; i < 2; ++i) { int R, C; stage_rc(tid * 16 + i * 8192, R, C); const int Rb = Epi::PERM ? ((R & ~31) + perm32(R & 31)) : R;
        voffA[i] = (unsigned)(R * K + C) * 2u; voffB[i] = (unsigned)(Rb * K + C) * 2u; }
    const size_t kstep = (size_t)(BK * 2);
    const size_t hstep = (size_t)HALF * K * 2;
    const size_t tstep = 2 * hstep;
    const unsigned ldsw = (unsigned)wid * 1024u;
    const int aoff = lds_byte(wr * 64 + fr, fq * 8), boff = lds_byte(wc * 32 + fr, fq * 8);
#define PG8_SA(b, h) (((b) * 2 + (h)) * HTB)
#define PG8_SB(b, h) ((4 + (b) * 2 + (h)) * HTB)
#define PG8_STAGE(bufoff, gbase, voff) do { _Pragma("unroll") for (int _i = 0; _i < 2; ++_i) \
        __builtin_amdgcn_global_load_lds((const unsigned*)((const char*)(gbase) + (voff)[_i]), (PG8_LAS unsigned*)(lds + (bufoff) + ldsw + _i * 8192), 16, 0, 0); } while (0)
#define PG8_LDA(dst, b, h) do { _Pragma("unroll") for (int m = 0; m < 4; ++m) _Pragma("unroll") for (int k = 0; k < 2; ++k) dst[m][k] = *(const PG8_LAS bf16x8*)(lds + PG8_SA(b, h) + aoff + m * 2048 + k * 1024); } while (0)
#define PG8_LDB(dst, b, h) do { _Pragma("unroll") for (int n = 0; n < 2; ++n) _Pragma("unroll") for (int k = 0; k < 2; ++k) dst[n][k] = *(const PG8_LAS bf16x8*)(lds + PG8_SB(b, h) + boff + n * 2048 + k * 1024); } while (0)
#define PG8_MMA(ai, bj, At, Bt) do { __builtin_amdgcn_s_setprio(1); _Pragma("unroll") for (int m = 0; m < 4; ++m) _Pragma("unroll") for (int n = 0; n < 2; ++n) _Pragma("unroll") for (int k = 0; k < 2; ++k) \
        acc[ai][bj][m][n] = __builtin_amdgcn_mfma_f32_16x16x32_bf16(Bt[n][k], At[m][k], acc[ai][bj][m][n], 0, 0, 0); __builtin_amdgcn_s_setprio(0); } while (0)
#define PG8_WAIT_V(n) asm volatile("s_waitcnt vmcnt(" #n ")" ::: "memory")
#define PG8_WAIT_L(n) asm volatile("s_waitcnt lgkmcnt(" #n ")" ::: "memory")
#define PG8_BAR __builtin_amdgcn_s_barrier()
#define PG8_SCHED __builtin_amdgcn_sched_barrier(0)
    Unit cur, nxt; int ui = 0;
    if (!S.next(0, cur)) return;
    f32x4 acc[2][2][4][2];
#pragma unroll
    for (int a = 0; a < 2; ++a)
#pragma unroll
        for (int b = 0; b < 2; ++b)
#pragma unroll
            for (int m = 0; m < 4; ++m)
#pragma unroll
                for (int n = 0; n < 2; ++n) acc[a][b][m][n] = (f32x4){0.f, 0.f, 0.f, 0.f};
    bf16x8 At[4][2], B0[2][2], B1[2][2];
    const char* cA = (const char*)g.A + (size_t)cur.pm * tstep; const char* cB = (const char*)g.Bt + (size_t)cur.pn * tstep;
    S.a_ready(cur);
    if constexpr (SP2) {
        PG8_STAGE(PG8_SB(0, 0), cB, voffB); PG8_STAGE(PG8_SB(0, 1), cB + hstep, voffB); PG8_STAGE(PG8_SA(0, 0), cA, voffA); PG8_STAGE(PG8_SA(0, 1), cA + hstep, voffA);
        if (wr == 1) PG8_BAR;
        PG8_WAIT_V(2); PG8_BAR;
        PG8_STAGE(PG8_SB(1, 0), cB + kstep, voffB); PG8_STAGE(PG8_SA(1, 0), cA + kstep, voffA); PG8_STAGE(PG8_SB(1, 1), cB + hstep + kstep, voffB);
        PG8_WAIT_V(6); PG8_BAR;
    } else {
        PG8_STAGE(PG8_SB(0, 0), cB, voffB); PG8_STAGE(PG8_SA(0, 0), cA, voffA); PG8_STAGE(PG8_SB(0, 1), cB + hstep, voffB); PG8_STAGE(PG8_SA(0, 1), cA + hstep, voffA);
        if (wr == 1) PG8_BAR;
        PG8_WAIT_V(4); PG8_BAR;
        PG8_STAGE(PG8_SB(1, 0), cB + kstep, voffB); PG8_STAGE(PG8_SA(1, 0), cA + kstep, voffA); PG8_STAGE(PG8_SB(1, 1), cB + hstep + kstep, voffB);
        PG8_WAIT_V(6); PG8_BAR;
    }
    for (;;) {
        const bool has_next = S.next(ui + 1, nxt);
        const char* nA = has_next ? (const char*)g.A + (size_t)nxt.pm * tstep : cA; const char* nB = has_next ? (const char*)g.Bt + (size_t)nxt.pn * tstep : cB;
        unsigned long long kt0_ = 0; if (PROBE_SEG == 5) kt0_ = __builtin_amdgcn_s_memrealtime(); if (PROBE_SEG == 6) kt0_ = __builtin_amdgcn_s_memtime();
        for (int t = 0; t < nt; t += 2) {
            const bool last = (t == nt - 2);
            const char* a1 = cA + (size_t)(t + 1) * kstep;
            const char* a2 = last ? nA : cA + (size_t)(t + 2) * kstep; const char* b2 = last ? nB : cB + (size_t)(t + 2) * kstep;
            const char* a3 = a2 + kstep; const char* b3 = b2 + kstep;
            if (last && has_next) S.a_ready(nxt);
            if constexpr (SP2) {
            PG8_LDB(B0, 0, 0); PG8_LDB(B1, 0, 1); PG8_SCHED; PG8_LDA(At, 0, 0); PG8_STAGE(PG8_SA(1, 1), a1 + hstep, voffA);
            PG8_WAIT_V(8); PG8_WAIT_L(0); PG8_BAR; PG8_MMA(0, 0, At, B0); PG8_MMA(0, 1, At, B1); PG8_BAR; PG8_SCHED;
            PG8_LDA(At, 0, 1); PG8_STAGE(PG8_SB(0, 0), b2, voffB); PG8_STAGE(PG8_SB(0, 1), b2 + hstep, voffB); PG8_STAGE(PG8_SA(0, 0), a2, voffA);
            PG8_WAIT_V(8); PG8_WAIT_L(0); PG8_BAR; PG8_MMA(1, 0, At, B0); PG8_MMA(1, 1, At, B1); PG8_BAR; PG8_SCHED;
            PG8_LDB(B0, 1, 0); PG8_LDB(B1, 1, 1); PG8_SCHED; PG8_LDA(At, 1, 0); PG8_STAGE(PG8_SA(0, 1), a2 + hstep, voffA);
            PG8_WAIT_V(8); PG8_WAIT_L(0); PG8_BAR; PG8_MMA(0, 0, At, B0); PG8_MMA(0, 1, At, B1); PG8_BAR; PG8_SCHED;
            PG8_LDA(At, 1, 1); PG8_STAGE(PG8_SB(1, 0), b3, voffB); PG8_STAGE(PG8_SB(1, 1), b3 + hstep, voffB); PG8_STAGE(PG8_SA(1, 0), a3, voffA);
            PG8_WAIT_V(8); PG8_WAIT_L(0); PG8_BAR; PG8_MMA(1, 0, At, B0); PG8_MMA(1, 1, At, B1); PG8_BAR; PG8_SCHED;
            } else {
            PG8_LDB(B0, 0, 0); PG8_SCHED; PG8_LDA(At, 0, 0); PG8_STAGE(PG8_SA(1, 1), a1 + hstep, voffA);
            PG8_WAIT_L(8); PG8_BAR; PG8_WAIT_L(0); PG8_MMA(0, 0, At, B0); PG8_BAR; PG8_SCHED;
            PG8_LDB(B1, 0, 1); PG8_STAGE(PG8_SB(0, 0), b2, voffB);
            PG8_BAR; PG8_WAIT_L(0); PG8_MMA(0, 1, At, B1); PG8_BAR;
            PG8_LDA(At, 0, 1); PG8_STAGE(PG8_SA(0, 0), a2, voffA);
            PG8_BAR; PG8_WAIT_L(0); PG8_MMA(1, 0, At, B0); PG8_BAR; PG8_SCHED;
            PG8_STAGE(PG8_SB(0, 1), b2 + hstep, voffB);
            PG8_WAIT_V(6); PG8_BAR; PG8_MMA(1, 1, At, B1); PG8_BAR;
            PG8_LDB(B0, 1, 0); PG8_SCHED; PG8_LDA(At, 1, 0); PG8_STAGE(PG8_SA(0, 1), a2 + hstep, voffA);
            PG8_WAIT_L(8); PG8_BAR; PG8_WAIT_L(0); PG8_MMA(0, 0, At, B0); PG8_BAR; PG8_SCHED;
            PG8_LDB(B1, 1, 1); PG8_STAGE(PG8_SB(1, 0), b3, voffB);
            PG8_BAR; PG8_WAIT_L(0); PG8_MMA(0, 1, At, B1); PG8_BAR;
            PG8_LDA(At, 1, 1); PG8_STAGE(PG8_SA(1, 0), a3, voffA);
            PG8_BAR; PG8_WAIT_L(0); PG8_MMA(1, 0, At, B0); PG8_BAR; PG8_SCHED;
            PG8_STAGE(PG8_SB(1, 1), b3 + hstep, voffB);
            PG8_WAIT_V(6); PG8_BAR; PG8_MMA(1, 1, At, B1); PG8_BAR;
            }
        }
        if (PROBE_SEG == 5 || PROBE_SEG == 6) { const unsigned long long kt1_ = (PROBE_SEG == 5) ? __builtin_amdgcn_s_memrealtime() : __builtin_amdgcn_s_memtime(); if (tid == 0) *(PG8_LAS unsigned long long*)(lds + 146432 + 64) += (PROBE_SEG == 5) ? (kt1_ - kt0_) : (kt1_ - kt0_) / 20; }
        if constexpr (ALIGN_EPI) { if (wr == 0) PG8_BAR; }
        if constexpr (!Epi::AFTER_DRAIN) { E(acc, cur, wr, wc, fr, fq); S.done(cur); }
        if (!has_next) break;
#pragma unroll
        for (int a = 0; a < 2; ++a)
#pragma unroll
            for (int b = 0; b < 2; ++b)
#pragma unroll
                for (int m = 0; m < 4; ++m)
#pragma unroll
                    for (int n = 0; n < 2; ++n) acc[a][b][m][n] = (f32x4){0.f, 0.f, 0.f, 0.f};
        cur = nxt; cA = nA; cB = nB; ++ui;
        if constexpr (ALIGN_EPI) { if (wr == 1) PG8_BAR; }
    }
    PG8_WAIT_V(0);
    if constexpr (!ALIGN_EPI) { if (wr == 0) PG8_BAR; }
    PG8_BAR;
    if constexpr (Epi::AFTER_DRAIN) { E.fused(acc, cur, wr, wc, fr, fq, lds, wid, lane); S.done(cur); }
#undef PG8_SA
#undef PG8_SB
#undef PG8_STAGE
#undef PG8_LDA
#undef PG8_LDB
#undef PG8_MMA
#undef PG8_WAIT_V
#undef PG8_WAIT_L
#undef PG8_BAR
#undef PG8_SCHED
}
}

namespace attn {
typedef unsigned short bf16_t;
using bf16x8 = __attribute__((ext_vector_type(8))) short;
using s16x4 = __attribute__((ext_vector_type(4))) short;
using f32x16 = __attribute__((ext_vector_type(16))) float;
using u32x4 = __attribute__((ext_vector_type(4))) unsigned;
constexpr int SEQ = 8192, DM = 1024, NW = 8, QBLK = 32, QB = 256, KVBLK = 64;
constexpr int SLOTB = 8192;
constexpr int NSLOT = 3;
constexpr int LDS_K = 0, LDS_V = NSLOT * SLOTB, LDS_KX = 2 * NSLOT * SLOTB, LDS_WS = LDS_KX + NSLOT * 1024, LDS_OST = LDS_WS + NW * 256, LDS_BYTES = LDS_OST + NW * 4096;
__device__ __forceinline__ int crow(int r, int hi) { return (r & 3) + 8 * (r >> 2) + 4 * hi; }
#define SBAR() __builtin_amdgcn_sched_barrier(0)
__device__ __forceinline__ void cmask(f32x16& p0, f32x16& p1, int jb, int qrel, int hi) {
    const float NEG = -INFINITY; const int kb = 64 * jb + 4 * hi;
#pragma unroll
    for (int r = 0; r < 16; ++r) { const int kv = kb + (r & 3) + 8 * (r >> 2); if (kv > qrel) p0[r] = NEG; if (kv + 32 > qrel) p1[r] = NEG; }
}
__device__ __forceinline__ void glds16(const void* gsrc, unsigned lds_dst) { unsigned keep;
    asm volatile("s_mov_b32 %0, m0\n\ts_mov_b32 m0, %2\n\ts_nop 0\n\tglobal_load_lds_dwordx4 %1, off\n\ts_mov_b32 m0, %0" : "=&s"(keep) : "v"(gsrc), "s"(lds_dst) : "memory"); }
typedef float f32x2_t __attribute__((ext_vector_type(2))); typedef __bf16 bf16x2_t __attribute__((ext_vector_type(2)));
__device__ __forceinline__ unsigned cvtpk_s(float lo, float hi) { f32x2_t v = {lo, hi}; bf16x2_t b = __builtin_convertvector(v, bf16x2_t); return __builtin_bit_cast(unsigned, b); }
__device__ __forceinline__ void pv(f32x16* o, int vb, bf16x8 pa0, bf16x8 pa1, bf16x8 pa2, bf16x8 pa3) {
#pragma unroll
    for (int d0 = 0; d0 < 2; ++d0) { s16x4 lo[4], hi[4];
#pragma unroll
        for (int ks = 0; ks < 4; ++ks) {
            asm volatile("ds_read_b64_tr_b16 %0,%1 offset:%c2" : "=&v"(lo[ks]) : "v"(vb), "i"(d0 * 4096 + ks * 1024) : "memory");
            asm volatile("ds_read_b64_tr_b16 %0,%1 offset:%c2" : "=&v"(hi[ks]) : "v"(vb), "i"(d0 * 4096 + ks * 1024 + 512) : "memory"); }
        asm volatile("s_waitcnt lgkmcnt(0)" ::: "memory"); SBAR();
#define PK(k) (bf16x8){lo[k][0], lo[k][1], lo[k][2], lo[k][3], hi[k][0], hi[k][1], hi[k][2], hi[k][3]}
        o[d0] = __builtin_amdgcn_mfma_f32_32x32x16_bf16(pa0, PK(0), o[d0], 0, 0, 0);
        o[d0] = __builtin_amdgcn_mfma_f32_32x32x16_bf16(pa1, PK(1), o[d0], 0, 0, 0);
        o[d0] = __builtin_amdgcn_mfma_f32_32x32x16_bf16(pa2, PK(2), o[d0], 0, 0, 0);
        o[d0] = __builtin_amdgcn_mfma_f32_32x32x16_bf16(pa3, PK(3), o[d0], 0, 0, 0);
#undef PK
    }
}
__device__ __forceinline__ int first_tile(const float* tlh, int qb, float limit, int lane) {
    const int tb = 4 * qb; if (tb == 0) return 0;
    const int t = tb - 1 - lane;
    float P = (t >= 0) ? __hip_atomic_load(tlh + (t >= 0 ? t : 0), __ATOMIC_RELAXED, __HIP_MEMORY_SCOPE_AGENT) : -1e30f;
#pragma unroll
    for (int o = 1; o < 64; o <<= 1) { const float u = __shfl_up(P, o); if (lane >= o) P += u; }
    float Dp = __shfl_up(P, 1); if (lane == 0) Dp = 0.f;
    const bool inc = (t >= 0) && (Dp >= -limit);
    const int n = __popcll(__ballot(inc));
    int tf = tb - n; if (n == 64 && tb > 64) tf = 0;
    return __builtin_amdgcn_readfirstlane(tf);
}
__device__ __forceinline__ void tile_offsets(const float* tlh, int NT, int lane, float& Dlo, float& Dhi) {
    const int t0 = NT - 1 - lane, t1 = NT - 65 - lane;
    const float T0 = (t0 >= 0) ? __hip_atomic_load(tlh + (t0 >= 0 ? t0 : 0), __ATOMIC_RELAXED, __HIP_MEMORY_SCOPE_AGENT) : 0.f;
    const float T1 = (t1 >= 0) ? __hip_atomic_load(tlh + (t1 >= 0 ? t1 : 0), __ATOMIC_RELAXED, __HIP_MEMORY_SCOPE_AGENT) : 0.f;
    float P0 = T0, P1 = T1;
#pragma unroll
    for (int o = 1; o < 64; o <<= 1) { const float u0 = __shfl_up(P0, o), u1 = __shfl_up(P1, o); if (lane >= o) { P0 += u0; P1 += u1; } }
    Dlo = P0 - T0; Dhi = __shfl(P0, 63) + (P1 - T1);
}
__device__ __forceinline__ void attn_unit(int b, int h, int qb, int tfirst, const bf16_t* Q, const bf16_t* K, const bf16_t* V, bf16_t* O, const bf16_t* kx, const float* gt, char* shm) {
    const int tid = threadIdx.x, lane = tid & 63, r32 = lane & 31, hi = lane >> 5; const int wid = __builtin_amdgcn_readfirstlane(tid >> 6);
    const long rowbase = (long)b * SEQ; const int q0 = qb * QB; const int bh = b * 16 + h;
    const bf16_t* Qw = Q + (rowbase + q0 + wid * QBLK) * DM + h * 64;
    const bf16_t* Kh = K + rowbase * DM + h * 64; const bf16_t* Vh = V + rowbase * DM + h * 64;
    const bf16_t* kxh = kx + (size_t)bh * SEQ * 8;
    const unsigned lds0 = (unsigned)(uintptr_t)shm;
    float* wsf = (float*)(shm + LDS_WS) + wid * 64;
    const int krow = 8 * wid + (lane >> 3);
    const bf16_t* ksrc = Kh + (long)krow * DM + (((lane & 7) ^ (krow & 7) ^ ((krow >> 4) & 1)) * 8);
    const bf16_t* vsrc = Vh + (long)(16 * (wid & 3) + (lane >> 2)) * DM + (wid >> 2) * 32 + (lane & 3) * 8;
    const bf16_t* xsrc = kxh + (long)lane * 8;
    const unsigned kdst = lds0 + LDS_K + wid * 1024, vdst = lds0 + LDS_V + wid * 1024, xdst = lds0 + LDS_KX;
    const int vb0 = (int)(lds0 + LDS_V) + ((lane >> 4) & 1) * 32 + (lane & 3) * 8 + (4 * hi + ((lane & 15) >> 2)) * 64;
    const int NT = (q0 + QB) / KVBLK;
    bf16x8 qr[4];
#pragma unroll
    for (int d0 = 0; d0 < 4; ++d0) qr[d0] = *reinterpret_cast<const bf16x8*>(&Qw[(long)r32 * DM + d0 * 16 + hi * 8]);
    const int jw = (NT - 4) * KVBLK + wid * QBLK + (QBLK - 1);
    const unsigned long long kxw = *reinterpret_cast<const unsigned long long*>(kxh + (long)jw * 8);
    float Dlo, Dhi; tile_offsets(gt + bh * 128, NT, lane, Dlo, Dhi);
    float Dw;
    { const unsigned w0 = (unsigned)__builtin_amdgcn_readfirstlane((int)(unsigned)kxw), w1 = (unsigned)__builtin_amdgcn_readfirstlane((int)(unsigned)(kxw >> 32));
      const float bj = (__uint_as_float(w0 << 16) + __uint_as_float(w0 & 0xffff0000u)) + __uint_as_float(w1 << 16);
      Dw = -(bj + __builtin_bit_cast(float, __builtin_amdgcn_readlane(__builtin_bit_cast(int, Dlo), 3 - (wid >> 1)))); }
    float l_reg = 0.f; f32x16 o[2]; o[0] = f32x16{}; o[1] = f32x16{};
    const int qrel = wid * QBLK + r32;
#define DMA_TILE(t, s) do { glds16(ksrc + (long)(t) * KVBLK * DM, (unsigned)__builtin_amdgcn_readfirstlane(kdst + (s) * SLOTB)); \
        glds16(vsrc + (long)(t) * KVBLK * DM, (unsigned)__builtin_amdgcn_readfirstlane(vdst + (s) * SLOTB)); \
        if (wid == 0) glds16(xsrc + (long)(t) * KVBLK * 8, (unsigned)__builtin_amdgcn_readfirstlane(xdst + (s) * 1024)); } while (0)
    DMA_TILE(tfirst, 0); if (tfirst + 1 < NT) DMA_TILE(tfirst + 1, 1);
    int s = 0;
    for (int t = tfirst; t < NT; ++t) {
        if (t + 1 < NT) { if (wid == 0) asm volatile("s_waitcnt vmcnt(3) lgkmcnt(0)" ::: "memory"); else asm volatile("s_waitcnt vmcnt(2) lgkmcnt(0)" ::: "memory"); }
        else asm volatile("s_waitcnt vmcnt(0) lgkmcnt(0)" ::: "memory");
        __builtin_amdgcn_s_barrier(); asm volatile("" ::: "memory");
        if (t + 2 < NT) { const int s2 = (s == 0) ? 2 : s - 1; DMA_TILE(t + 2, s2); }
        const int jb = t - (NT - 4);
        if (jb <= (wid >> 1)) {
        bf16x8 qx;
        { const int ti = NT - 1 - t; const float D = Dw + __builtin_bit_cast(float, ti < 64 ? __builtin_amdgcn_readlane(__builtin_bit_cast(int, Dlo), ti) : __builtin_amdgcn_readlane(__builtin_bit_cast(int, Dhi), ti - 64));
          const unsigned h1 = cvtpk_s(D, D) & 0xffffu; const float r1 = D - __uint_as_float(h1 << 16);
          const unsigned h2 = cvtpk_s(r1, r1) & 0xffffu; const float r2 = r1 - __uint_as_float(h2 << 16);
          const unsigned h3 = cvtpk_s(r2, r2) & 0xffffu;
          u32x4 qw = (u32x4){0u, 0u, 0u, 0u}; if (hi == 0) { qw.x = 0x3F803F80u; qw.y = 0x3F80u | (h1 << 16); qw.z = h2 | (h3 << 16); }
          qx = __builtin_bit_cast(bf16x8, qw); }
        f32x16 p0, p1;
        { const char* kb = shm + LDS_K + s * SLOTB + r32 * 128; const int ksw = (r32 & 7) ^ ((r32 >> 4) & 1); const char* xb = shm + LDS_KX + s * 1024 + r32 * 16;
          const bf16x8 x0 = *reinterpret_cast<const bf16x8*>(xb), x1 = *reinterpret_cast<const bf16x8*>(xb + 512);
          p0 = __builtin_amdgcn_mfma_f32_32x32x16_bf16(x0, qx, f32x16{}, 0, 0, 0); p1 = __builtin_amdgcn_mfma_f32_32x32x16_bf16(x1, qx, f32x16{}, 0, 0, 0);
#pragma unroll
          for (int d0 = 0; d0 < 4; ++d0) { const int ko = ((2 * d0 + hi) ^ ksw) * 16; const bf16x8 b0 = *reinterpret_cast<const bf16x8*>(kb + ko), b1 = *reinterpret_cast<const bf16x8*>(kb + ko + 4096);
              p0 = __builtin_amdgcn_mfma_f32_32x32x16_bf16(b0, qr[d0], p0, 0, 0, 0); p1 = __builtin_amdgcn_mfma_f32_32x32x16_bf16(b1, qr[d0], p1, 0, 0, 0); } }
        if (jb == (wid >> 1)) cmask(p0, p1, jb, qrel, hi);
        float sacc = 0.f;
#pragma unroll
        for (int r = 0; r < 16; ++r) { p0[r] = __builtin_amdgcn_exp2f(p0[r]); p1[r] = __builtin_amdgcn_exp2f(p1[r]); sacc += p0[r] + p1[r]; }
        l_reg += sacc;
        u32x4 pw0, pw1, pw2, pw3;
#define PKW(P, B) cvtpk_s(P[B], P[B + 1])
        pw0 = (u32x4){PKW(p0, 0), PKW(p0, 2), PKW(p0, 4), PKW(p0, 6)}; pw1 = (u32x4){PKW(p0, 8), PKW(p0, 10), PKW(p0, 12), PKW(p0, 14)};
        pw2 = (u32x4){PKW(p1, 0), PKW(p1, 2), PKW(p1, 4), PKW(p1, 6)}; pw3 = (u32x4){PKW(p1, 8), PKW(p1, 10), PKW(p1, 12), PKW(p1, 14)};
#undef PKW
        SBAR();
        pv(o, vb0 + s * SLOTB, __builtin_bit_cast(bf16x8, pw0), __builtin_bit_cast(bf16x8, pw1), __builtin_bit_cast(bf16x8, pw2), __builtin_bit_cast(bf16x8, pw3));
        }
        s = (s == 2) ? 0 : s + 1;
    }
#undef DMA_TILE
    { auto rr = __builtin_amdgcn_permlane32_swap(__float_as_uint(l_reg), __float_as_uint(l_reg), false, false); l_reg = __uint_as_float(rr[0]) + __uint_as_float(rr[1]); }
    if (hi == 0) wsf[32 + r32] = l_reg; asm volatile("s_waitcnt lgkmcnt(0)" ::: "memory");
    float rli[16];
#pragma unroll
    for (int r = 0; r < 16; ++r) rli[r] = __builtin_amdgcn_rcpf(wsf[32 + crow(r, hi)]);
    bf16_t* Ow = O + (rowbase + q0 + wid * QBLK) * DM + h * 64;
    { __hip_bfloat16* stg = (__hip_bfloat16*)(shm + LDS_OST) + wid * 2048;
#pragma unroll
      for (int r = 0; r < 16; ++r) { const int orow = crow(r, hi);
#pragma unroll
          for (int d0 = 0; d0 < 2; ++d0) stg[orow * 64 + d0 * 32 + r32] = __float2bfloat16(o[d0][r] * rli[r]); }
      asm volatile("s_waitcnt lgkmcnt(0)" ::: "memory");
#pragma unroll
      for (int i = 0; i < 4; ++i) { const int row = i * 8 + (lane >> 3), ch = lane & 7; const u32x4 v = *(const u32x4*)(stg + row * 64 + ch * 8); st16_wt(Ow + (long)row * DM + ch * 8, v); } }
    asm volatile("s_waitcnt lgkmcnt(0)\n\ts_barrier" ::: "memory");
}
#undef SBAR
}

namespace ssd {
typedef unsigned short bf16_t;
using bf16x8 = __attribute__((ext_vector_type(8))) short;
using s16x4 = __attribute__((ext_vector_type(4))) short;
using f32x16 = __attribute__((ext_vector_type(16))) float;
using f32x4 = __attribute__((ext_vector_type(4))) float;
using u32x4 = __attribute__((ext_vector_type(4))) unsigned;
using u32x2 = __attribute__((ext_vector_type(2))) unsigned;
constexpr int SEQ = 8192, L = 128, NCH = 64, XBC = 4096;
constexpr float LOG2E = 1.4426950408889634f;
typedef __attribute__((address_space(3))) unsigned char* lptr;
#define SSD_LF const __attribute__((address_space(3))) float*
__device__ __forceinline__ int crow(int r, int hi) { return (r & 3) + 8 * (r >> 2) + 4 * hi; }
__device__ __forceinline__ unsigned cvtpk(float lo, float hi) { unsigned r; asm volatile("v_cvt_pk_bf16_f32 %0, %1, %2" : "=v"(r) : "v"(lo), "v"(hi)); return r; }
__device__ __forceinline__ float silu_f(float x) { return x * __builtin_amdgcn_rcpf(1.0f + __builtin_amdgcn_exp2f(-LOG2E * x)); }
__device__ __forceinline__ s16x4 vtr(lptr p) { typedef short v4i16_t __attribute__((ext_vector_type(4))); return __builtin_bit_cast(s16x4, __builtin_amdgcn_ds_read_tr16_b64_v4i16((__attribute__((address_space(3))) v4i16_t*)p)); }
#define SSD_BAR() do { asm volatile("s_waitcnt vmcnt(0) lgkmcnt(0)" ::: "memory"); __builtin_amdgcn_s_barrier(); asm volatile("" ::: "memory"); } while (0)
__device__ __forceinline__ void glds16(const void* gsrc, unsigned lds_dst) { unsigned keep;
    asm volatile("s_mov_b32 %0, m0\n\ts_mov_b32 m0, %2\n\ts_nop 0\n\tglobal_load_lds_dwordx4 %1, off\n\ts_mov_b32 m0, %0" : "=&s"(keep) : "v"(gsrc), "s"(lds_dst) : "memory"); }
__device__ __forceinline__ void glds16s(const void* sbase, unsigned voff, unsigned lds_dst) { unsigned keep;
    asm volatile("s_mov_b32 %0, m0\n\ts_mov_b32 m0, %2\n\ts_nop 0\n\tglobal_load_lds_dwordx4 %1, %3\n\ts_mov_b32 m0, %0" : "=&s"(keep) : "v"(voff), "s"(lds_dst), "s"(sbase) : "memory"); }

constexpr int IMG_X = 0;
constexpr int IMG_B = 65536;
constexpr int IMG_C = 98304;
constexpr int TAB = 131072;
constexpr int TAB_AC = TAB, TAB_DT = TAB + 2048, TAB_SS = TAB + 6144, TAB_NW = TAB + 8192, TAB_MISC = TAB + 9216;

struct Raw11 { u32x4 r[11]; };
__device__ __forceinline__ void raw_load(Raw11& R, const bf16_t* xb_batch, const bf16_t* halo3  , int t0, int rg, int ch) {
#pragma unroll
    for (int i = 0; i < 3; ++i) { if (rg != 0) R.r[i] = *(const u32x4*)(xb_batch + (size_t)(t0 - 3 + i) * XBC + ch); else R.r[i] = halo3 ? *(const u32x4*)(halo3 + (size_t)i * XBC + ch) : (u32x4){0u, 0u, 0u, 0u}; }
#pragma unroll
    for (int i = 0; i < 8; ++i) R.r[3 + i] = *(const u32x4*)(xb_batch + (size_t)(t0 + i) * XBC + ch);
}
__device__ __forceinline__ void conv_rows(const Raw11& R, int ch, const float* cw, const float* cb, float (&out)[8][8]) {
    f32x4 w[4][2], bias[2];
#pragma unroll
    for (int k = 0; k < 4; ++k) { w[k][0] = *(const f32x4*)(cw + k * XBC + ch); w[k][1] = *(const f32x4*)(cw + k * XBC + ch + 4); }
    bias[0] = *(const f32x4*)(cb + ch); bias[1] = *(const f32x4*)(cb + ch + 4);
#pragma unroll
    for (int r = 0; r < 8; ++r)
#pragma unroll
        for (int hh = 0; hh < 2; ++hh) { f32x4 a = bias[hh];
#pragma unroll
            for (int k = 0; k < 4; ++k) { const unsigned w0 = R.r[r + k][2 * hh], w1 = R.r[r + k][2 * hh + 1];
                const f32x4 xv = (f32x4){__uint_as_float(w0 << 16), __uint_as_float(w0 & 0xffff0000u), __uint_as_float(w1 << 16), __uint_as_float(w1 & 0xffff0000u)};
                a = w[k][hh] * xv + a; }
            f32x4 e = a * (-LOG2E);
            e[0] = __builtin_amdgcn_exp2f(e[0]); e[1] = __builtin_amdgcn_exp2f(e[1]); e[2] = __builtin_amdgcn_exp2f(e[2]); e[3] = __builtin_amdgcn_exp2f(e[3]);
            e = e + 1.0f;
            e[0] = __builtin_amdgcn_rcpf(e[0]); e[1] = __builtin_amdgcn_rcpf(e[1]); e[2] = __builtin_amdgcn_rcpf(e[2]); e[3] = __builtin_amdgcn_rcpf(e[3]);
            a = a * e;
            out[r][4 * hh] = a[0]; out[r][4 * hh + 1] = a[1]; out[r][4 * hh + 2] = a[2]; out[r][4 * hh + 3] = a[3]; }
}
__device__ __forceinline__ void tables_load(lptr lds, const float* dt, const float* acl, const float* tot, int row0, int g, int tid) {
    if (tid < 128) { const f32x4 d = *(const f32x4*)(dt + (size_t)(row0 + tid) * 32 + 4 * g); f32x4 a = *(const f32x4*)(acl + (size_t)(row0 + tid) * 32 + 4 * g);
        if (tid >= 64) a = a + *(const f32x4*)(tot + (size_t)(row0 >> 6) * 32 + 4 * g);
        __attribute__((address_space(3))) float* ac = (__attribute__((address_space(3))) float*)(lds + TAB_AC); __attribute__((address_space(3))) float* dtt = (__attribute__((address_space(3))) float*)(lds + TAB_DT);
#pragma unroll
        for (int k = 0; k < 4; ++k) { ac[k * 128 + tid] = a[k]; dtt[k * 128 + tid] = d[k]; } }
}

__device__ __forceinline__ void s2_unit(lptr lds, int b, int c, int g, bf16_t* xbc, const bf16_t* halo, const float* dt, const float* acl, const float* tot, const float* cw, const float* cb, bf16_t* st_b, float* cdec) {
    const int tid = threadIdx.x, lane = tid & 63, r32 = lane & 31, hi = lane >> 5; const int wid = __builtin_amdgcn_readfirstlane(tid >> 6);
    const int row0 = b * SEQ + c * L; bf16_t* xbat = xbc + (size_t)b * SEQ * XBC; const bf16_t* halo3 = (c > 0) ? halo + (size_t)(row0 >> 7) * 3 * XBC : nullptr;
    const int cg1 = tid & 31, rg1 = tid >> 5, ch1 = 256 * g + 8 * cg1;
    const int cg2 = tid & 15, rg2 = (tid & 255) >> 4, isC = tid >> 8, ch2 = 2048 + 1024 * isC + 128 * g + 8 * cg2;
    u32x4 pk1[8], pk2[8];
    { Raw11 R1; raw_load(R1, xbat, halo3, c * L + rg1 * 8, rg1, ch1);
      const int k = cg1 >> 3, hcol = 4 * g + k;
      float wl[8];
      { const float ta = acl[(size_t)(row0 + 127) * 32 + hcol] + tot[(size_t)(row0 >> 6) * 32 + hcol];
        const float t0h = (rg1 >= 8) ? tot[(size_t)(row0 >> 6) * 32 + hcol] : 0.f;
#pragma unroll
        for (int r = 0; r < 8; ++r) { const size_t ro = (size_t)(row0 + rg1 * 8 + r) * 32 + hcol; wl[r] = __builtin_amdgcn_exp2f(ta - (acl[ro] + t0h)) * dt[ro]; } }
      float out[8][8]; conv_rows(R1, ch1, cw, cb, out);
#pragma unroll
      for (int r = 0; r < 8; ++r) { const int l = rg1 * 8 + r; const float w = wl[r];
          pk1[r].x = cvtpk(out[r][0], out[r][1]); pk1[r].y = cvtpk(out[r][2], out[r][3]); pk1[r].z = cvtpk(out[r][4], out[r][5]); pk1[r].w = cvtpk(out[r][6], out[r][7]);
          u32x4 sx; sx.x = cvtpk(out[r][0] * w, out[r][1] * w); sx.y = cvtpk(out[r][2] * w, out[r][3] * w); sx.z = cvtpk(out[r][4] * w, out[r][5] * w); sx.w = cvtpk(out[r][6] * w, out[r][7] * w);
          *(__attribute__((address_space(3))) u32x4*)(lds + IMG_X + (cg1 >> 2) * 8192 + l * 64 + (cg1 & 3) * 16) = sx; } }
    { Raw11 R2; raw_load(R2, xbat, halo3, c * L + rg2 * 8, rg2, ch2);
      float out[8][8]; conv_rows(R2, ch2, cw, cb, out);
#pragma unroll
      for (int r = 0; r < 8; ++r) { const int l = rg2 * 8 + r;
          pk2[r].x = cvtpk(out[r][0], out[r][1]); pk2[r].y = cvtpk(out[r][2], out[r][3]); pk2[r].z = cvtpk(out[r][4], out[r][5]); pk2[r].w = cvtpk(out[r][6], out[r][7]);
          if (!isC) *(__attribute__((address_space(3))) u32x4*)(lds + IMG_B + (cg2 >> 2) * 8192 + l * 64 + (cg2 & 3) * 16) = pk2[r]; } }
    if (tid < 4) { const int hcol = 4 * g + tid; cdec[(size_t)(b * NCH + c) * 32 + hcol] = __builtin_amdgcn_exp2f(acl[(size_t)(row0 + 127) * 32 + hcol] + tot[(size_t)(row0 >> 6) * 32 + hcol]); }
    SSD_BAR();
#pragma unroll
    for (int r = 0; r < 8; ++r) { st16_wt(xbat + (size_t)(c * L + rg1 * 8 + r) * XBC + ch1, pk1[r]); st16_wt(xbat + (size_t)(c * L + rg2 * 8 + r) * XBC + ch2, pk2[r]); }
    const int k = wid >> 1, nh = wid & 1;
    f32x16 acc[2][2];
#pragma unroll
    for (int i = 0; i < 2; ++i)
#pragma unroll
        for (int j = 0; j < 2; ++j) acc[i][j] = f32x16{};
    const int lanepat = (4 * hi + ((lane & 15) >> 2)) * 64 + ((lane >> 4) & 1) * 32 + (lane & 3) * 8;
#pragma unroll 2
    for (int ks = 0; ks < 8; ++ks) {
        bf16x8 af[2], bf[2];
#pragma unroll
        for (int i = 0; i < 2; ++i) { const lptr pa = lds + IMG_B + (2 * nh + i) * 8192 + ks * 1024 + lanepat; const s16x4 lo = vtr(pa), hh = vtr(pa + 512); af[i] = (bf16x8){lo[0], lo[1], lo[2], lo[3], hh[0], hh[1], hh[2], hh[3]};
                                      const lptr pb = lds + IMG_X + (2 * k + i) * 8192 + ks * 1024 + lanepat; const s16x4 lo2 = vtr(pb), hh2 = vtr(pb + 512); bf[i] = (bf16x8){lo2[0], lo2[1], lo2[2], lo2[3], hh2[0], hh2[1], hh2[2], hh2[3]}; }
#pragma unroll
        for (int i = 0; i < 2; ++i)
#pragma unroll
            for (int j = 0; j < 2; ++j) acc[i][j] = __builtin_amdgcn_mfma_f32_32x32x16_bf16(af[i], bf[j], acc[i][j], 0, 0, 0);
    }
    SSD_BAR();
#pragma unroll
    for (int i = 0; i < 2; ++i)
#pragma unroll
        for (int j = 0; j < 2; ++j)
#pragma unroll
            for (int rq = 0; rq < 4; ++rq) {
                u32x2 o; o.x = cvtpk(acc[i][j][4 * rq], acc[i][j][4 * rq + 1]); o.y = cvtpk(acc[i][j][4 * rq + 2], acc[i][j][4 * rq + 3]);
                *(__attribute__((address_space(3))) u32x2*)(lds + IMG_X + k * 16384 + (((j * 8 + 4 * nh + 2 * i + (rq >> 1)) * 64 + 32 * (rq & 1) + r32) * 16) + 8 * hi) = o; }
    SSD_BAR();
    { bf16_t* dst = st_b + ((size_t)c * 32 + 4 * g) * 8192;
#pragma unroll
      for (int i = 0; i < 8; ++i) { const int off = (i * 512 + tid) * 16; st16_wt((char*)dst + off, *(const __attribute__((address_space(3))) u32x4*)(lds + IMG_X + off)); } }
    asm volatile("s_waitcnt lgkmcnt(0)" ::: "memory"); __builtin_amdgcn_s_barrier(); asm volatile("" ::: "memory");
}

__device__ __forceinline__ void s3_scan(bf16_t* st0, bf16_t* st1, const float* cdec, int vcu, int G) {
    const int tid = threadIdx.x;
    for (int item = vcu; item < 256; item += G) {
        const int b = item >> 7, h = (item >> 2) & 31, qd = item & 3;
        bf16_t* base = (b == 0 ? st0 : st1) + (size_t)h * 8192 + qd * 2048 + tid * 4;
        const float* dc = cdec + (size_t)b * NCH * 32 + h;
        float hs[4] = {0.f, 0.f, 0.f, 0.f};
        const float dl = __hip_atomic_load(dc + (tid & 63) * 32, __ATOMIC_RELAXED, __HIP_MEMORY_SCOPE_AGENT);
#pragma unroll 1
        for (int c0 = 0; c0 < NCH; c0 += 8) {
            u32x2 v[8]; float d[8];
#pragma unroll
            for (int i = 0; i < 8; ++i) { v[i] = *(const u32x2*)(base + (size_t)(c0 + i) * 32 * 8192); d[i] = __builtin_bit_cast(float, __builtin_amdgcn_readlane(__builtin_bit_cast(int, dl), c0 + i)); }
#pragma unroll
            for (int i = 0; i < 8; ++i) { u32x2 o; o.x = cvtpk(hs[0], hs[1]); o.y = cvtpk(hs[2], hs[3]); *(u32x2*)(base + (size_t)(c0 + i) * 32 * 8192) = o;
                hs[0] = d[i] * hs[0] + __uint_as_float(v[i].x << 16); hs[1] = d[i] * hs[1] + __uint_as_float(v[i].x & 0xffff0000u);
                hs[2] = d[i] * hs[2] + __uint_as_float(v[i].y << 16); hs[3] = d[i] * hs[3] + __uint_as_float(v[i].y & 0xffff0000u); }
        }
    }
}

__device__ __forceinline__ void s4_phase(lptr lds, int vcu, int G, const bf16_t* xbc, const float* dt, const float* acl, const float* tot,
                                         const bf16_t* st0, const bf16_t* st1, const float* dskip, const float* normw, bf16_t* zy) {
    const int tid = threadIdx.x, lane = tid & 63, r32 = lane & 31, hi = lane >> 5; const int wid = __builtin_amdgcn_readfirstlane(tid >> 6);
    const unsigned lds0 = (unsigned)(uintptr_t)lds;
    const unsigned vx = (unsigned)(((lane >> 2) * XBC + 8 * (lane & 3)) * 2);
    __attribute__((address_space(3))) float* ssh = (__attribute__((address_space(3))) float*)(lds + TAB_SS);
    __attribute__((address_space(3))) float* nwt = (__attribute__((address_space(3))) float*)(lds + TAB_NW);
    SSD_LF ac = (SSD_LF)(lds + TAB_AC); SSD_LF dtt = (SSD_LF)(lds + TAB_DT);
    const int k = wid >> 1, lh = wid & 1;
    const int lanepat = (4 * hi + ((lane & 15) >> 2)) * 64 + ((lane >> 4) & 1) * 32 + (lane & 3) * 8;
    const int swt = 16 * (hi ^ (r32 & 15));
#define S4_DMA_X(uu) do { const int b_ = (uu) >> 9, c_ = ((uu) >> 3) & 63, g_ = (uu) & 7; const char* xg_ = (const char*)(xbc + (size_t)(b_ * SEQ + c_ * L) * XBC + 256 * g_); \
        _Pragma("unroll") for (int i_ = 0; i_ < 8; ++i_) { const int pi_ = wid * 8 + i_, blk_ = pi_ >> 3, rgp_ = pi_ & 7; \
            glds16s(xg_ + (size_t)(16 * rgp_) * XBC * 2 + 64 * blk_, vx, (unsigned)__builtin_amdgcn_readfirstlane(lds0 + IMG_X + blk_ * 8192 + rgp_ * 1024)); } } while (0)
    int u = vcu; if (u >= 1024) return;
    S4_DMA_X(u);
    for (; u < 1024; u += G) {
        const int b = u >> 9, c = (u >> 3) & 63, g = u & 7, h = 4 * g + k;
        const int row0 = b * SEQ + c * L; const bf16_t* xrow = xbc + (size_t)row0 * XBC;
        { const char* bg = (const char*)(xrow + 2048 + 128 * g);
#pragma unroll
          for (int i = 0; i < 4; ++i) { const int pi = wid * 4 + i; const int prow = 4 * pi + (lane >> 4);
              const unsigned vb = (unsigned)((prow * XBC + 8 * ((lane & 15) ^ (prow & 15))) * 2);
              glds16s(bg, vb, (unsigned)__builtin_amdgcn_readfirstlane(lds0 + IMG_B + pi * 1024));
              glds16s(bg + 2048, vb, (unsigned)__builtin_amdgcn_readfirstlane(lds0 + IMG_C + pi * 1024)); } }
        { int tid_ = tid; asm volatile("" : "+v"(tid_));
          tables_load(lds, dt, acl, tot, row0, g, tid_);
          if (tid_ < 256) nwt[tid_] = normw[256 * g + tid_]; }
        SSD_BAR();
        const bf16_t* prev = (b == 0 ? st0 : st1) + ((size_t)c * 32 + h) * 8192;
        f32x16 yT[2][2];
#pragma unroll
        for (int lt = 0; lt < 2; ++lt) {
            const int Lt = lt == 0 ? lh : 3 - lh; const int l = 32 * Lt + r32; const float acl_ = ac[k * 128 + l];
            yT[lt][0] = f32x16{}; yT[lt][1] = f32x16{};
#define SSD_CF(ks) (*(const __attribute__((address_space(3))) bf16x8*)(lds + ((IMG_C + l * 256 + swt) ^ ((ks) * 32))))
            for (int st = 0; st <= Lt; ++st) {
                f32x16 cbt = f32x16{};
#pragma unroll
                for (int ks = 0; ks < 8; ++ks) { const bf16x8 bfr = *(const __attribute__((address_space(3))) bf16x8*)(lds + ((IMG_B + (32 * st + r32) * 256 + swt) ^ (ks * 32)));
                    cbt = __builtin_amdgcn_mfma_f32_32x32x16_bf16(bfr, SSD_CF(ks), cbt, 0, 0, 0); }
#pragma unroll
                for (int rq = 0; rq < 4; ++rq) { const int s0 = 32 * st + 8 * rq + 4 * hi;
                    const f32x4 as = *(const __attribute__((address_space(3))) f32x4*)(ac + k * 128 + s0), ds = *(const __attribute__((address_space(3))) f32x4*)(dtt + k * 128 + s0);
#pragma unroll
                    for (int j = 0; j < 4; ++j) { float w = cbt[4 * rq + j] * __builtin_amdgcn_exp2f(acl_ - as[j]) * ds[j]; if (s0 + j > l) w = 0.f; cbt[4 * rq + j] = w; } }
                bf16x8 wb[2];
#pragma unroll
                for (int sp = 0; sp < 2; ++sp) { u32x4 pk; pk.x = cvtpk(cbt[8 * sp], cbt[8 * sp + 1]); pk.y = cvtpk(cbt[8 * sp + 2], cbt[8 * sp + 3]); pk.z = cvtpk(cbt[8 * sp + 4], cbt[8 * sp + 5]); pk.w = cvtpk(cbt[8 * sp + 6], cbt[8 * sp + 7]); wb[sp] = __builtin_bit_cast(bf16x8, pk); }
#pragma unroll
                for (int pt = 0; pt < 2; ++pt)
#pragma unroll
                    for (int sp = 0; sp < 2; ++sp) { const lptr pa = lds + IMG_X + (2 * k + pt) * 8192 + (32 * st + 16 * sp) * 64 + lanepat; const s16x4 lo = vtr(pa), hh = vtr(pa + 512);
                        const bf16x8 xf = (bf16x8){lo[0], lo[1], lo[2], lo[3], hh[0], hh[1], hh[2], hh[3]};
                        yT[lt][pt] = __builtin_amdgcn_mfma_f32_32x32x16_bf16(xf, wb[sp], yT[lt][pt], 0, 0, 0); }
            }
            const float eal = __builtin_amdgcn_exp2f(acl_);
#pragma unroll
            for (int pt = 0; pt < 2; ++pt) { f32x16 t = f32x16{};
#pragma unroll
                for (int kh = 0; kh < 2; ++kh) { bf16x8 pf[4];
#pragma unroll
                    for (int ks = 0; ks < 4; ++ks) pf[ks] = *(const bf16x8*)(prev + (size_t)((pt * 8 + 4 * kh + ks) * 64 + lane) * 8);
#pragma unroll
                    for (int ks = 0; ks < 4; ++ks) t = __builtin_amdgcn_mfma_f32_32x32x16_bf16(pf[ks], SSD_CF(4 * kh + ks), t, 0, 0, 0); }
#pragma unroll
                for (int r = 0; r < 16; ++r) yT[lt][pt][r] += t[r] * eal; }
            const float dk = dskip[h];
#pragma unroll
            for (int pt = 0; pt < 2; ++pt)
#pragma unroll
                for (int rq = 0; rq < 4; ++rq) { const u32x2 xv = *(const __attribute__((address_space(3))) u32x2*)(lds + IMG_X + (2 * k + pt) * 8192 + l * 64 + (8 * rq + 4 * hi) * 2);
                    yT[lt][pt][4 * rq] += dk * __uint_as_float(xv.x << 16); yT[lt][pt][4 * rq + 1] += dk * __uint_as_float(xv.x & 0xffff0000u);
                    yT[lt][pt][4 * rq + 2] += dk * __uint_as_float(xv.y << 16); yT[lt][pt][4 * rq + 3] += dk * __uint_as_float(xv.y & 0xffff0000u); }
        }
#undef SSD_CF
#pragma unroll
        for (int lt = 0; lt < 2; ++lt) { const int l = 32 * (lt == 0 ? lh : 3 - lh) + r32; float ss = 0.f;
            const bf16_t* zrow = zy + (size_t)(row0 + l) * 2048 + 256 * g + 64 * k + 8 * hi;
#pragma unroll
            for (int pt = 0; pt < 2; ++pt) { u32x2 zv[4];
#pragma unroll
                for (int j = 0; j < 2; ++j) { const u32x4 zc = *(const u32x4*)(zrow + 32 * pt + 16 * j);
                    const auto sx = __builtin_amdgcn_permlane32_swap(zc.x, zc.z, false, false); const auto sy = __builtin_amdgcn_permlane32_swap(zc.y, zc.w, false, false);
                    zv[2 * j].x = sx[0]; zv[2 * j].y = sy[0]; zv[2 * j + 1].x = sx[1]; zv[2 * j + 1].y = sy[1]; }
#pragma unroll
                for (int rq = 0; rq < 4; ++rq) {
                    float v0 = yT[lt][pt][4 * rq] * __uint_as_float(zv[rq].x << 16), v1 = yT[lt][pt][4 * rq + 1] * __uint_as_float(zv[rq].x & 0xffff0000u);
                    float v2 = yT[lt][pt][4 * rq + 2] * __uint_as_float(zv[rq].y << 16), v3 = yT[lt][pt][4 * rq + 3] * __uint_as_float(zv[rq].y & 0xffff0000u);
                    yT[lt][pt][4 * rq] = v0; yT[lt][pt][4 * rq + 1] = v1; yT[lt][pt][4 * rq + 2] = v2; yT[lt][pt][4 * rq + 3] = v3; ss += (v0 * v0 + v1 * v1) + (v2 * v2 + v3 * v3); } }
            ss += __shfl_xor(ss, 32);
            if (hi == 0) ssh[k * 128 + l] = ss; }
        SSD_BAR();
        if (u + G < 1024) S4_DMA_X(u + G);
#pragma unroll
        for (int lt = 0; lt < 2; ++lt) { const int l = 32 * (lt == 0 ? lh : 3 - lh) + r32;
            const float totq = (ssh[l] + ssh[128 + l]) + (ssh[256 + l] + ssh[384 + l]); const float rs = __builtin_amdgcn_rsqf(totq * (1.0f / 256.0f) + 1e-6f);
#pragma unroll
            for (int pt = 0; pt < 2; ++pt)
#pragma unroll
                for (int rq = 0; rq < 4; ++rq) { const int chn = 64 * k + 32 * pt + 8 * rq + 4 * hi; const f32x4 nw = *(const __attribute__((address_space(3))) f32x4*)(nwt + chn);
                    u32x2 o; o.x = cvtpk(yT[lt][pt][4 * rq] * rs * nw[0], yT[lt][pt][4 * rq + 1] * rs * nw[1]); o.y = cvtpk(yT[lt][pt][4 * rq + 2] * rs * nw[2], yT[lt][pt][4 * rq + 3] * rs * nw[3]);
                    *(__attribute__((address_space(3))) u32x2*)(lds + IMG_B + l * 512 + chn * 2) = o; } }
        asm volatile("s_waitcnt lgkmcnt(0)" ::: "memory"); __builtin_amdgcn_s_barrier(); asm volatile("" ::: "memory");
        { bf16_t* ydst = zy + (size_t)row0 * 2048 + 256 * g;
#pragma unroll
          for (int i = 0; i < 8; ++i) { const int idx = i * 512 + tid; const int r = idx >> 5, ch = idx & 31;
              st16_wt(ydst + (size_t)r * 2048 + ch * 8, *(const __attribute__((address_space(3))) u32x4*)(lds + IMG_B + r * 512 + ch * 16)); } }
        asm volatile("s_waitcnt lgkmcnt(0)" ::: "memory"); __builtin_amdgcn_s_barrier(); asm volatile("" ::: "memory");
    }
#undef S4_DMA_X
}
#undef SSD_LF
}

namespace misc {
typedef unsigned short bf16_t;
typedef float f32x4 __attribute__((ext_vector_type(4)));
typedef unsigned u32x4 __attribute__((ext_vector_type(4)));
typedef unsigned u32x2 __attribute__((ext_vector_type(2)));
typedef short bf16x8 __attribute__((ext_vector_type(8)));
typedef __attribute__((address_space(3))) unsigned char* lptr;
typedef __attribute__((address_space(3))) float* lfptr;
constexpr float LOG2E = 1.4426950408889634f;
__device__ __forceinline__ unsigned cvtpk(float lo, float hi) { unsigned r; asm volatile("v_cvt_pk_bf16_f32 %0, %1, %2" : "=v"(r) : "v"(lo), "v"(hi)); return r; }
#define MISC_BAR() do { asm volatile("s_waitcnt vmcnt(0) lgkmcnt(0)" ::: "memory"); __builtin_amdgcn_s_barrier(); asm volatile("" ::: "memory"); } while (0)

enum { MAP_ID = 0, MAP_CONV_IN = 1, MAP_FOX_IN = 2, MAP_GU = 3 };
template <int MAP> __device__ __forceinline__ int src_col32(int nb) {
    const int n = nb * 32;
    if (MAP == MAP_ID) return n;
    if (MAP == MAP_CONV_IN) { const int pn = n >> 8, t = n & 255; return pn < 8 ? ((t >> 7) ? 2048 : 1024) + 128 * pn + (t & 127) : 256 * (pn - 8) + t; }
    if (MAP == MAP_FOX_IN) { const int pn = n >> 8, t = n & 255; const int bj = t >> 7, wc = (t >> 5) & 3; return 256 * pn + 64 * wc + 32 * bj; }
      { const int pn = n >> 8, t = n & 255; return (t >> 7) * 2816 + 128 * pn + (t & 127); }
}
template <int MAP> struct TItem { f32x4 v[8]; bf16_t* dst; };
template <int MAP> __device__ __forceinline__ void titem_load(TItem<MAP>& T, const float* W, int K, int Nsrc, int Ndst, const float* nw, bf16_t* WT, int item, int lane) {
    const int nblk = Ndst / 32, kb = item / nblk, nb = item % nblk, k0 = 64 * kb, n0 = 32 * nb, s0 = src_col32<MAP>(nb); const int kg = lane >> 3, nc = lane & 7;
    const float* src = W + (size_t)(k0 + 8 * kg) * Nsrc + s0 + 4 * nc;
#pragma unroll
    for (int i = 0; i < 8; ++i) T.v[i] = __builtin_nontemporal_load((const f32x4*)(src + (size_t)i * Nsrc));
    if (nw) { const f32x4 w0 = *(const f32x4*)(nw + k0 + 8 * kg), w1 = *(const f32x4*)(nw + k0 + 8 * kg + 4);
#pragma unroll
        for (int i = 0; i < 4; ++i) { T.v[i] = T.v[i] * w0[i]; T.v[4 + i] = T.v[4 + i] * w1[i]; } }
    T.dst = WT + (size_t)(n0 + 4 * nc) * K + k0 + 8 * kg;
}
template <int MAP> __device__ __forceinline__ void titem_store(const TItem<MAP>& T, int K) {
#pragma unroll
    for (int j = 0; j < 4; ++j) { u32x4 o; o.x = cvtpk(T.v[0][j], T.v[1][j]); o.y = cvtpk(T.v[2][j], T.v[3][j]); o.z = cvtpk(T.v[4][j], T.v[5][j]); o.w = cvtpk(T.v[6][j], T.v[7][j]);
        st16_wt(T.dst + (size_t)j * K, o); }
}
template <int MAP> __device__ __forceinline__ void transpose_job(const float* W, int K, int Nsrc, int Ndst, const float* nw, bf16_t* WT, int gw, int NGW, int lane) {
    const int nitems = (K / 64) * (Ndst / 32);
    int it = gw;
    for (; it + 3 * NGW < nitems; it += 4 * NGW) { TItem<MAP> A, B, C, D;
        titem_load<MAP>(A, W, K, Nsrc, Ndst, nw, WT, it, lane); titem_load<MAP>(B, W, K, Nsrc, Ndst, nw, WT, it + NGW, lane);
        titem_load<MAP>(C, W, K, Nsrc, Ndst, nw, WT, it + 2 * NGW, lane); titem_load<MAP>(D, W, K, Nsrc, Ndst, nw, WT, it + 3 * NGW, lane);
        titem_store<MAP>(A, K); titem_store<MAP>(B, K); titem_store<MAP>(C, K); titem_store<MAP>(D, K); }
    for (; it < nitems; it += NGW) { TItem<MAP> A; titem_load<MAP>(A, W, K, Nsrc, Ndst, nw, WT, it, lane); titem_store<MAP>(A, K); }
}
__device__ __forceinline__ void gate_cols(const float* W, int Nsrc, int c0, int ncol, const float* nw, bf16_t* WT, int gtid, int gthreads) {
    for (int idx = gtid; idx < ncol * 1024; idx += gthreads) { const int n = idx >> 10, k = idx & 1023; const float v = W[(size_t)k * Nsrc + c0 + n] * nw[k];
        WT[idx] = (bf16_t)(cvtpk(v, v) & 0xffffu); }
}
__device__ __forceinline__ void row_pass2(const float* xrow, bf16_t* xbrow, float* ssqrow, int lane) {
    f32x4 v[2][4]; float s[2] = {0.f, 0.f};
#pragma unroll
    for (int r = 0; r < 2; ++r)
#pragma unroll
        for (int j = 0; j < 4; ++j) v[r][j] = __builtin_nontemporal_load((const f32x4*)(xrow + r * 1024) + 2 * lane + (j & 1) + 128 * (j >> 1));
#pragma unroll
    for (int r = 0; r < 2; ++r) { f32x4 sq = (f32x4){0.f, 0.f, 0.f, 0.f};
#pragma unroll
        for (int jj = 0; jj < 2; ++jj) { const f32x4 a = v[r][2 * jj], b = v[r][2 * jj + 1]; sq = a * a + sq; sq = b * b + sq;
            u32x4 w; w.x = cvtpk(a[0], a[1]); w.y = cvtpk(a[2], a[3]); w.z = cvtpk(b[0], b[1]); w.w = cvtpk(b[2], b[3]); ((u32x4*)(xbrow + r * 1024) + lane)[64 * jj] = w; }
        s[r] = (sq[0] + sq[1]) + (sq[2] + sq[3]);
#pragma unroll
        for (int o = 1; o < 64; o <<= 1) s[r] += __shfl_xor(s[r], o);
    }
    if (lane < 8) ssqrow[lane] = (lane == 0) ? s[0] : (lane == 4) ? s[1] : 0.f;
}
template <int NC> __device__ __forceinline__ void mini_gemm(lptr lds, const bf16_t* xb, const bf16_t* wg, const float* ssq, int row0, int tid) {
    const int lane = tid & 63, wid = tid >> 6, r16 = lane & 15, kg = lane >> 4;
    f32x4 acc[4][NC / 16];
#pragma unroll
    for (int rb = 0; rb < 4; ++rb)
#pragma unroll
        for (int nb = 0; nb < NC / 16; ++nb) acc[rb][nb] = (f32x4){0.f, 0.f, 0.f, 0.f};
#pragma unroll
    for (int ks = 0; ks < 4; ++ks) { const int k0 = 128 * wid + 32 * ks + 8 * kg;
        bf16x8 bfr[NC / 16];
#pragma unroll
        for (int nb = 0; nb < NC / 16; ++nb) bfr[nb] = *(const bf16x8*)(wg + (size_t)(16 * nb + r16) * 1024 + k0);
#pragma unroll
        for (int rb = 0; rb < 4; ++rb) { const bf16x8 afr = *(const bf16x8*)(xb + (size_t)(row0 + 16 * rb + r16) * 1024 + k0);
#pragma unroll
            for (int nb = 0; nb < NC / 16; ++nb) acc[rb][nb] = __builtin_amdgcn_mfma_f32_16x16x32_bf16(afr, bfr[nb], acc[rb][nb], 0, 0, 0); } }
    lfptr part = (lfptr)lds + wid * 64 * NC;
#pragma unroll
    for (int rb = 0; rb < 4; ++rb)
#pragma unroll
        for (int nb = 0; nb < NC / 16; ++nb)
#pragma unroll
            for (int j = 0; j < 4; ++j) part[(16 * rb + 4 * kg + j) * NC + 16 * nb + r16] = acc[rb][nb][j];
    MISC_BAR();
    lfptr red = (lfptr)lds + 8 * 64 * NC;
    for (int idx = tid; idx < 64 * NC; idx += 512) { float s = 0.f;
#pragma unroll
        for (int w = 0; w < 8; ++w) s += ((lfptr)lds)[w * 64 * NC + idx];
        const int row = row0 + idx / NC; const f32x4 a = *(const f32x4*)(ssq + (size_t)row * 4);
        const float t = (a[0] + a[1]) + (a[2] + a[3]);
        red[idx] = s * __builtin_amdgcn_rsqf(t * (1.0f / 1024.0f) + 1e-6f); }
    MISC_BAR();
}
__device__ __forceinline__ void fox_gate_task(lptr lds, const bf16_t* xb, const bf16_t* wg, const float* ssq, const float* b_f, bf16_t* kx, float* gt, float* tl, int task, int tid) {
    const int row0 = task * 64; mini_gemm<16>(lds, xb, wg, ssq, row0, tid);
    const lfptr red = (lfptr)lds + 8 * 64 * 16; const int lane = tid & 63, wid = tid >> 6; const int b = row0 >> 13, tile = (row0 & 8191) >> 6;
#pragma unroll
    for (int hh = 0; hh < 2; ++hh) { const int h = 2 * wid + hh; const float xg = red[lane * 16 + h] + b_f[h];
        const float lf2 = -(fmaxf(-xg, 0.f) * LOG2E + __builtin_amdgcn_logf(1.0f + __builtin_amdgcn_exp2f(-fabsf(xg) * LOG2E)));
        float p = lf2;
#pragma unroll
        for (int o = 1; o < 64; o <<= 1) { const float t = __shfl_up(p, o); if (lane >= o) p += t; }
        const float tot = __shfl(p, 63); const float bias = tot - p;
        const unsigned h1 = cvtpk(bias, bias) & 0xffffu; const float r1 = bias - __uint_as_float(h1 << 16);
        const unsigned h2 = cvtpk(r1, r1) & 0xffffu; const float r2 = r1 - __uint_as_float(h2 << 16);
        const unsigned h3 = cvtpk(r2, r2) & 0xffffu;
        const int bh = b * 16 + h; u32x4 o; o.x = h1 | (h2 << 16); o.y = h3 | (0x3F80u << 16); o.z = 0x3F803F80u; o.w = 0u;
        *(u32x4*)(kx + ((size_t)bh * 8192 + (row0 & 8191) + lane) * 8) = o;
        if (lane == 0) { gt[bh * 128 + tile] = __builtin_amdgcn_exp2f(tot); tl[bh * 128 + tile] = tot; } }
    MISC_BAR();
}
__device__ __forceinline__ void ssd_dt_task(lptr lds, const bf16_t* xb, const bf16_t* wg, const float* ssq, const float* dt_bias, const float* a_log, float* dt, float* acl, float* tot, int task, int tid) {
    const int row0 = task * 64; mini_gemm<32>(lds, xb, wg, ssq, row0, tid);
    const lfptr red = (lfptr)lds + 8 * 64 * 32; const int lane = tid & 63, wid = tid >> 6;
    f32x4 spv, pv;
#pragma unroll
    for (int hh = 0; hh < 4; ++hh) { const int h = 4 * wid + hh; const float xg = red[lane * 32 + h] + dt_bias[h];
        const float sp = fmaxf(xg, 0.f) + 0.6931471805599453f * __builtin_amdgcn_logf(1.0f + __builtin_amdgcn_exp2f(-fabsf(xg) * LOG2E));
        float p = sp * (-__builtin_amdgcn_exp2f(LOG2E * a_log[h])) * LOG2E;
#pragma unroll
        for (int o = 1; o < 64; o <<= 1) { const float t = __shfl_up(p, o); if (lane >= o) p += t; }
        spv[hh] = sp; pv[hh] = p; }
    *(f32x4*)(dt + (size_t)(row0 + lane) * 32 + 4 * wid) = spv; *(f32x4*)(acl + (size_t)(row0 + lane) * 32 + 4 * wid) = pv;
    if (lane == 63) *(f32x4*)(tot + (size_t)task * 32 + 4 * wid) = pv;
    MISC_BAR();
}
}

#define GAS __attribute__((address_space(1)))
#define LAS __attribute__((address_space(3)))
typedef unsigned short bf16;
typedef unsigned v4u __attribute__((ext_vector_type(4)));
typedef float f32x4 __attribute__((ext_vector_type(4)));
typedef short bf16x8 __attribute__((ext_vector_type(8)));
typedef GAS unsigned gu32;
typedef GAS unsigned long long gu64;
#define RLX_AGENT __ATOMIC_RELAXED, __HIP_MEMORY_SCOPE_AGENT
#define LDS_WAIT() asm volatile("s_waitcnt lgkmcnt(0)" ::: "memory")
#define VM_WAIT() asm volatile("s_waitcnt vmcnt(0)" ::: "memory")
__device__ __forceinline__ unsigned long long rt() { return __builtin_amdgcn_s_memrealtime(); }
__device__ __forceinline__ unsigned f2bf(float f) { unsigned u = __builtin_bit_cast(unsigned, f); return (u + 0x7fffu + ((u >> 16) & 1u)) >> 16; }
__device__ __forceinline__ unsigned pk2(float lo, float hi) { return f2bf(lo) | (f2bf(hi) << 16); }

#define XB_TMO      128
#define XB_XCNT(j)  (256  + 64 * (j))
#define XB_XSUB(j)  (1280 + 64 * (j))
#define XB_XGEN(j)  (2304 + 64 * (j))
#define XB_TOP      3328
#define XB_TOPGEN   3392
#define XCD_BAR_WORDS 3456
#define XB_SPIN_CAP (1u << 18)

__device__ __forceinline__ unsigned xb_ld(unsigned* p)              { return __hip_atomic_load(p, __ATOMIC_RELAXED, __HIP_MEMORY_SCOPE_AGENT); }
__device__ __forceinline__ unsigned xb_add(unsigned* p, unsigned v) { return __hip_atomic_fetch_add(p, v, __ATOMIC_RELAXED, __HIP_MEMORY_SCOPE_AGENT); }
__device__ __forceinline__ unsigned xb_xcc_id() { return (unsigned)__builtin_amdgcn_s_getreg((3 << 11) | 20) & 0xFu; }
#define XB_SPIN(cond, bar) do { unsigned _sp = 0; while (cond) { __builtin_amdgcn_s_sleep(1); \
    if ((++_sp & 255u) == 0u) { if (xb_ld(&(bar)[XB_TMO])) break; if (_sp > XB_SPIN_CAP) { atomicAdd(&(bar)[XB_TMO], 1u); break; } } } } while (0)

struct XcdBarrier {
    unsigned* bar; unsigned x;
    volatile LAS unsigned* st;
};

__device__ __forceinline__ XcdBarrier xcd_barrier_post(unsigned* bar, volatile LAS unsigned* st) {
    XcdBarrier b; b.bar = bar; b.x = xb_xcc_id(); b.st = st;
    if (threadIdx.x == 0) (void)xb_add(&bar[XB_XCNT(b.x)], 1u);
    return b;
}
__device__ __forceinline__ void xcd_barrier_complete(unsigned* bar, unsigned x, unsigned& nloc, unsigned& nx) {
    const unsigned G = gridDim.x * gridDim.y * gridDim.z;
    unsigned sum, cnt, mine, sp = 0u;
    for (;;) {
        sum = 0u; cnt = 0u; mine = 0u;
#pragma unroll
        for (unsigned j = 0; j < 16; ++j) { const unsigned c = xb_ld(&bar[XB_XCNT(j)]); sum += c; cnt += (c > 0u) ? 1u : 0u; mine = (j == x) ? c : mine; }
        if (sum == G) break;
        __builtin_amdgcn_s_sleep(1);
        if ((++sp & 255u) == 0u) { if (xb_ld(&bar[XB_TMO])) break; if (sp > XB_SPIN_CAP) { atomicAdd(&bar[XB_TMO], 1u); break; } }
    }
    nloc = mine > 0u ? mine : 1u; nx = cnt > 0u ? cnt : 1u;
}

__device__ __forceinline__ void xcd_barrier(const XcdBarrier& b) {
    asm volatile("s_waitcnt vmcnt(0)" ::: "memory");
    __syncthreads();
    if (threadIdx.x == 0) {
        unsigned* bar = b.bar;
        __builtin_amdgcn_s_waitcnt(0);
        unsigned nloc = b.st[0], nx = b.st[1];
        if (nloc == 0u) { xcd_barrier_complete(bar, b.x, nloc, nx); b.st[0] = nloc; b.st[1] = nx; }
        const unsigned old = xb_add(&bar[XB_XSUB(b.x)], 1u);
        const unsigned gen = old / nloc;
        if (old + 1u == (gen + 1u) * nloc) {
            __builtin_amdgcn_fence(__ATOMIC_RELEASE, "agent");
            asm volatile("s_waitcnt vmcnt(0)" ::: "memory");
            asm volatile("buffer_inv sc1" ::: "memory");
            const unsigned og = xb_add(&bar[XB_TOP], 1u);
            const unsigned tg = og / nx;
            if (og + 1u == (tg + 1u) * nx) xb_add(&bar[XB_TOPGEN], 1u);
            else XB_SPIN(xb_ld(&bar[XB_TOPGEN]) == tg, bar);
            asm volatile("s_waitcnt vmcnt(0)" ::: "memory");
            xb_add(&bar[XB_XGEN(b.x)], 1u);
            asm volatile("s_waitcnt vmcnt(0)" ::: "memory");
        } else {
            asm volatile("buffer_inv sc1" ::: "memory");
            XB_SPIN(xb_ld(&bar[XB_XGEN(b.x)]) == gen, bar);
            asm volatile("s_waitcnt vmcnt(0)" ::: "memory");
        }
    }
    __syncthreads();
}

constexpr int NWAVES = 8;
#ifndef MK_N_LAUNCHES
#define MK_N_LAUNCHES 1
#endif
constexpr int M = 16384, DMODEL = 1024, FF = 2816, NGU = 5632, SEQ = 8192;
constexpr size_t MiB = 1u << 20;
constexpr size_t WS_CTL = 0, CTL_ZERO_BYTES = 64 * 1024;
constexpr size_t WS_W = 1 * MiB;
constexpr size_t SZ_CIN = (size_t)3072 * 1024 * 2, SZ_SQ = (size_t)1024 * 1024 * 2, SZ_GU = (size_t)NGU * 1024 * 2, SZ_DN = (size_t)1024 * FF * 2, SZ_SIN = (size_t)6144 * 1024 * 2, SZ_SOUT = (size_t)1024 * 2048 * 2;
constexpr size_t W_L0_IN = WS_W, W_L0_OUT = W_L0_IN + SZ_CIN, W_L0_GU = W_L0_OUT + SZ_SQ, W_L0_DN = W_L0_GU + SZ_GU;
constexpr size_t W_L1_IN = W_L0_DN + SZ_DN, W_L1_OUT = W_L1_IN + SZ_CIN, W_L1_GU = W_L1_OUT + SZ_SQ, W_L1_DN = W_L1_GU + SZ_GU;
constexpr size_t W_L2_IN = W_L1_DN + SZ_DN, W_L2_OUT = W_L2_IN + SZ_SIN, W_L2_GU = W_L2_OUT + SZ_SOUT, W_L2_DN = W_L2_GU + SZ_GU;
constexpr size_t W_L3_IN = W_L2_DN + SZ_DN, W_L3_OUT = W_L3_IN + SZ_CIN, W_L3_GU = W_L3_OUT + SZ_SQ, W_L3_DN = W_L3_GU + SZ_GU;
constexpr size_t W_END = W_L3_DN + SZ_DN;
static_assert(W_END <= 107 * MiB, "weights");
constexpr size_t WS_WGATE = 107 * MiB;
constexpr size_t WS_XB = 108 * MiB;
constexpr size_t WS_SSQ = 140 * MiB;
constexpr size_t WS_KX = 141 * MiB;
constexpr size_t WS_DT = 145 * MiB;
constexpr size_t WS_GT = 147 * MiB;
constexpr size_t WS_T = 148 * MiB;
constexpr size_t WS_H = WS_T;
constexpr size_t WS_CV = WS_T, WS_Y = WS_T + 32 * MiB;
constexpr size_t WS_Q = WS_T;
constexpr size_t WS_ZY = WS_T, WS_XBC = WS_T + 64 * MiB;
constexpr size_t WS_ST1 = WS_W;
constexpr size_t WS_HALO = WS_XBC + 128 * MiB;
constexpr size_t WS_ACL = WS_HALO + 4 * MiB, WS_TOT = WS_ACL + 2 * MiB;
constexpr size_t WS_END = WS_TOT + 1 * MiB;
static_assert(WS_ST1 + 32 * MiB <= W_L2_IN, "states of batch 1 must only cover dead weights");
static_assert(WS_END == 347 * MiB, "ws map");
constexpr int CW_FLAG = 16;
constexpr int CW_BAR = 1024;
constexpr int RING_OFF = 0, RING_BYTES = 131072;
constexpr int LDSCTL_OFF = 146432, MISC_OFF = LDSCTL_OFF + 320;
constexpr int LDS_BYTES = 147456;
static_assert(attn::LDS_BYTES <= RING_BYTES && ssd::TAB_MISC + 64 <= LDSCTL_OFF, "LDS map");

struct Args { const float* in[21]; float* out; unsigned char* ws; int ph_lo, ph_hi; };
enum { PH_PRO = 0, PH_L0_IN, PH_L0_MIX, PH_L0_OUT, PH_L0_GU, PH_L0_DN,
       PH_L1_IN, PH_L1_ATT, PH_L1_OUT, PH_L1_GU, PH_L1_DN,
       PH_L2_IN, PH_L2_S2, PH_L2_S3, PH_L2_S4, PH_L2_OUT, PH_L2_GU, PH_L2_DN,
       PH_L3_IN, PH_L3_MIX, PH_L3_OUT, PH_L3_GU, PH_L3_DN, PH_COUNT };

__global__ void __launch_bounds__(NWAVES * 64, 2) mega_fwd(Args args) {
    extern __shared__ __attribute__((aligned(16))) unsigned char lds[];
    LAS unsigned char* const L = (LAS unsigned char*)lds;
    const int tid = threadIdx.x, lane = tid & 63, wave = __builtin_amdgcn_readfirstlane(tid >> 6);
    const int G = gridDim.x; const int bx = blockIdx.x; const int vcu = (G % 8 == 0) ? (bx % 8) * (G / 8) + bx / 8 : bx;
    unsigned char* const ws = args.ws;
    gu32* const ctl = (gu32*)(ws + WS_CTL);
    for (int u = tid; u < (LDS_BYTES - LDSCTL_OFF) / 4; u += NWAVES * 64) ((LAS unsigned*)(L + LDSCTL_OFF))[u] = 0u;
    __syncthreads();
    XcdBarrier bar; bar.bar = (unsigned*)(ctl + CW_BAR); bar.x = 0; bar.st = nullptr;
    if (MK_N_LAUNCHES == 1) bar = xcd_barrier_post((unsigned*)(ctl + CW_BAR), (volatile LAS unsigned*)(L + MISC_OFF) + 8);
    const int lo = args.ph_lo, hi = args.ph_hi;
#define IN(k) (lo <= (k) && (k) < hi)
#ifndef PROBE_MASK
#define PROBE_MASK 0ull
#endif
#ifndef PROBE_MULT
#define PROBE_MULT 1ull
#endif
#ifndef PROBE_SKEW
#define PROBE_SKEW 0ull
#define PROBE_SKEWSTAT 0
#endif
    unsigned long long pr_seg = 0; unsigned long long pr_t0 = 0, pr_acc = 0;
    if (PROBE_MASK != 0ull) pr_t0 = __builtin_amdgcn_s_memrealtime();
#define SEAM(k) do { if (IN(k) && IN((k) + 1)) { unsigned long long bt0_ = 0; if (PROBE_SEG == 7) bt0_ = __builtin_amdgcn_s_memrealtime(); if (PROBE_SEG == 8 && tid == 0) ((unsigned long long*)(ws + WS_END))[(k) * 256 + bx] = __builtin_amdgcn_s_memrealtime(); xcd_barrier(bar); if (PROBE_SEG == 7) pr_seg += __builtin_amdgcn_s_memrealtime() - bt0_; } \
    if (PROBE_MASK != 0ull) { const unsigned long long now_ = __builtin_amdgcn_s_memrealtime(); if ((PROBE_MASK >> (k)) & 1ull) pr_acc += now_ - pr_t0; pr_t0 = now_; } } while (0)
    typedef pg8::bf16_t bf16_t;
    float* const X = args.out;
    bf16_t* const XB = (bf16_t*)(ws + WS_XB); float* const SSQ = (float*)(ws + WS_SSQ);
    const float* const mix_norm = args.in[1]; const float* const ffn_norm = args.in[2];

#define RUN_JOB(Wp, K_, NS_, ND_, MAP_, NWp, DST_, GW_, NGW_) misc::transpose_job<MAP_>((Wp), (K_), (NS_), (ND_), (NWp), (bf16_t*)(ws + (DST_)), (GW_), (NGW_), lane)
#define CONVERT_LAYERS(LMASK_, GW_, NGW_) do { \
        for (int i_ = 0; i_ < 4; ++i_) if (((LMASK_) >> i_) & 1) { \
            const size_t gu_dst = (i_ == 0 ? W_L0_GU : i_ == 1 ? W_L1_GU : i_ == 2 ? W_L2_GU : W_L3_GU), dn_dst = (i_ == 0 ? W_L0_DN : i_ == 1 ? W_L1_DN : i_ == 2 ? W_L2_DN : W_L3_DN); \
            RUN_JOB(args.in[3] + (size_t)i_ * 1024 * NGU, 1024, NGU, NGU, misc::MAP_GU, ffn_norm + i_ * 1024, gu_dst, GW_, NGW_); \
            RUN_JOB(args.in[4] + (size_t)i_ * FF * 1024, FF, 1024, 1024, misc::MAP_ID, (const float*)nullptr, dn_dst, GW_, NGW_); \
            if (i_ == 0 || i_ == 3) { const int j_ = i_ == 0 ? 0 : 1; \
                RUN_JOB(args.in[5] + (size_t)j_ * 1024 * 3072, 1024, 3072, 3072, misc::MAP_CONV_IN, mix_norm + i_ * 1024, (j_ == 0 ? W_L0_IN : W_L3_IN), GW_, NGW_); \
                RUN_JOB(args.in[7] + (size_t)j_ * 1024 * 1024, 1024, 1024, 1024, misc::MAP_ID, (const float*)nullptr, (j_ == 0 ? W_L0_OUT : W_L3_OUT), GW_, NGW_); } \
            if (i_ == 1) { RUN_JOB(args.in[8], 1024, 3088, 3072, misc::MAP_FOX_IN, mix_norm + 1024, W_L1_IN, GW_, NGW_); RUN_JOB(args.in[12], 1024, 1024, 1024, misc::MAP_ID, (const float*)nullptr, W_L1_OUT, GW_, NGW_); } \
            if (i_ == 2) { RUN_JOB(args.in[13], 1024, 6176, 6144, misc::MAP_ID, mix_norm + 2048, W_L2_IN, GW_, NGW_); RUN_JOB(args.in[20], 2048, 1024, 1024, misc::MAP_ID, (const float*)nullptr, W_L2_OUT, GW_, NGW_); } } } while (0)
    const bool late_convert = (G == 256);
    if (IN(PH_PRO)) {
        const int gw = vcu * NWAVES + wave, NGW = G * NWAVES;
        CONVERT_LAYERS((late_convert ? 1 : 15), gw, NGW);
        misc::gate_cols(args.in[8], 3088, 3072, 16, mix_norm + 1024, (bf16_t*)(ws + WS_WGATE), vcu * 512 + tid, G * 512);
        misc::gate_cols(args.in[13], 6176, 6144, 32, mix_norm + 2048, (bf16_t*)(ws + WS_WGATE + 65536), vcu * 512 + tid, G * 512);
        for (int m = 2 * gw; m < M; m += 2 * NGW) misc::row_pass2(args.in[0] + (size_t)m * 1024, XB + (size_t)m * 1024, SSQ + (size_t)m * 4, lane);
        asm volatile("s_waitcnt vmcnt(0) lgkmcnt(0)" ::: "memory"); __syncthreads();
    }
    SEAM(PH_PRO);

#define FFN_PHASES(PH_GU_, PH_DN_, WGU_, WDN_, RMODE_, NEXTL_) do { \
    if (IN(PH_GU_)) { pg8::Gemm g{XB, (const bf16_t*)(ws + (WGU_)), M, NGU, 1024}; pg8::StaticOrder S; S.init(M, NGU, G, bx); \
        pg8::EpiGU E{(bf16_t*)(ws + WS_H), SSQ}; pg8::gemm_phase<pg8::EpiGU, pg8::StaticOrder, true, true>(L + RING_OFF, g, S, E); \
        if (late_convert && (NEXTL_) < 4 && bx >= 128) { CONVERT_LAYERS((1 << (NEXTL_)), (bx - 128) * NWAVES + wave, 128 * NWAVES); } } \
    SEAM(PH_GU_); \
    if (IN(PH_DN_)) { pg8::Gemm g{(const bf16_t*)(ws + WS_H), (const bf16_t*)(ws + (WDN_)), M, 1024, FF}; pg8::StaticOrder S; S.init(M, 1024, G, bx); \
        pg8::EpiResid<RMODE_> E{nullptr, X, XB, SSQ, (LAS float*)(L + 131072)}; pg8::gemm_phase<pg8::EpiResid<RMODE_>, pg8::StaticOrder, true, true>(L + RING_OFF, g, S, E); } \
    SEAM(PH_DN_); } while (0)
#define CONV_LAYER(PH_IN_, PH_MIX_, PH_OUT_, WIN_, WOUT_, J_, RMODE_) do { \
    if (IN(PH_IN_)) { pg8::Gemm g{XB, (const bf16_t*)(ws + (WIN_)), M, 2048, 1024}; pg8::StaticOrder S; S.init(M, 2048, G, bx);             \
        pg8::EpiConvIn E{(bf16_t*)(ws + WS_CV), SSQ}; pg8::gemm_phase<pg8::EpiConvIn, pg8::StaticOrder, true, true>(L + RING_OFF, g, S, E); } \
    SEAM(PH_IN_); \
    if (IN(PH_MIX_)) { pg8::Gemm g{XB, (const bf16_t*)(ws + (WIN_)) + (size_t)2048 * 1024, M, 1024, 1024}; pg8::StaticOrder S; S.init(M, 1024, G, bx);     \
        pg8::EpiConvB E{(const bf16_t*)(ws + WS_CV), (bf16_t*)(ws + WS_Y), SSQ, args.in[6] + (J_) * 3 * 1024, (LAS float*)(L + 131072)}; pg8::gemm_phase<pg8::EpiConvB, pg8::StaticOrder, true, true>(L + RING_OFF, g, S, E); } \
    SEAM(PH_MIX_); \
    if (IN(PH_OUT_)) { pg8::Gemm g{(const bf16_t*)(ws + WS_Y), (const bf16_t*)(ws + (WOUT_)), M, 1024, 1024}; pg8::StaticOrder S; S.init(M, 1024, G, bx); \
        pg8::EpiResid<RMODE_> E{args.in[0], X, XB, SSQ, (LAS float*)(L + 131072)}; pg8::gemm_phase<pg8::EpiResid<RMODE_>, pg8::StaticOrder, true, true>(L + RING_OFF, g, S, E); } \
    SEAM(PH_OUT_); } while (0)

    CONV_LAYER(PH_L0_IN, PH_L0_MIX, PH_L0_OUT, W_L0_IN, W_L0_OUT, 0, 0);
    FFN_PHASES(PH_L0_GU, PH_L0_DN, W_L0_GU, W_L0_DN, 1, 1);

    if (IN(PH_L1_IN)) {
        pg8::Gemm g{XB, (const bf16_t*)(ws + W_L1_IN), M, 3072, 1024}; pg8::StaticOrder S; S.init(M, 3072, G, bx);
        pg8::EpiFoxIn E{(bf16_t*)(ws + WS_Q), SSQ, args.in[10], args.in[11], 0.125f * 1.4426950408889634f};
        pg8::gemm_phase<pg8::EpiFoxIn, pg8::StaticOrder, true, true>(L + RING_OFF, g, S, E);
        for (int task = vcu; task < M / 64; task += G)
            misc::fox_gate_task((misc::lptr)(L + RING_OFF), XB, (const bf16_t*)(ws + WS_WGATE), SSQ, args.in[9], (bf16_t*)(ws + WS_KX), (float*)(ws + WS_GT), (float*)(ws + WS_GT + 65536), task, tid);
    }
    SEAM(PH_L1_IN);
    if (IN(PH_L1_ATT)) {
        float limit;
        { float gq = fabsf(args.in[10][lane]), gk = fabsf(args.in[11][lane]);
#pragma unroll
          for (int o = 1; o < 64; o <<= 1) { gq = fmaxf(gq, __shfl_xor(gq, o)); gk = fmaxf(gk, __shfl_xor(gk, o)); }
          limit = 45.0f + 2.05f * (8.0f * 1.4426950408889634f) * gq * gk; }
        const float* TL = (const float*)(ws + WS_GT + 65536);
        LAS float* hc = (LAS float*)(L + 131072); LAS int* hperm = (LAS int*)(L + 131072 + 128);
        if (G == 256) {
#pragma unroll
            for (int k = 0; k < 4; ++k) { const int h = 4 * wave + k; float v = TL[h * 128 + lane] + TL[h * 128 + 64 + lane];
#pragma unroll
                for (int o = 1; o < 64; o <<= 1) v += __shfl_xor(v, o);
                if (lane == 0) hc[h] = v; }
            __syncthreads();
            if (tid < 32) { const float my = hc[tid]; int rank = 0;
                for (int j = 0; j < 32; ++j) { const float o = hc[j]; rank += (o > my || (o == my && j < tid)) ? 1 : 0; }
                hperm[rank] = tid; }
            __syncthreads();
        }
        for (int i = 0; i < 4; ++i) {
            int qb, bh;
            if (G == 256) { qb = (vcu >> 5) + 8 * i; const int c = vcu & 31; const int rk = (i == 0) ? c : (i == 1) ? 31 - ((c + 16) & 31) : (i == 2) ? ((c + 16) & 31) : 31 - c;
                            bh = __builtin_amdgcn_readfirstlane(hperm[rk]) & 31; }
            else { const int u = vcu + i * G; if (u >= 1024) break; qb = u >> 5; bh = u & 31; }
            const int tf = attn::first_tile(TL + bh * 128, qb, limit, lane);
            attn::attn_unit(bh >> 4, bh & 15, qb, tf, (const bf16_t*)(ws + WS_Q), (const bf16_t*)(ws + WS_Q + 32 * MiB), (const bf16_t*)(ws + WS_Q + 64 * MiB), (bf16_t*)(ws + WS_Q),
                            (const bf16_t*)(ws + WS_KX), (const float*)(ws + WS_GT + 65536), (char*)lds + RING_OFF);
        }
        asm volatile("s_waitcnt vmcnt(0)" ::: "memory"); __syncthreads();
    }
    SEAM(PH_L1_ATT);
    if (IN(PH_L1_OUT)) { pg8::Gemm g{(const bf16_t*)(ws + WS_Q), (const bf16_t*)(ws + W_L1_OUT), M, 1024, 1024}; pg8::StaticOrder S; S.init(M, 1024, G, bx);
        pg8::EpiResid<1> E{nullptr, X, XB, SSQ, (LAS float*)(L + 131072)}; pg8::gemm_phase<pg8::EpiResid<1>, pg8::StaticOrder, true, true>(L + RING_OFF, g, S, E); }
    SEAM(PH_L1_OUT);
    FFN_PHASES(PH_L1_GU, PH_L1_DN, W_L1_GU, W_L1_DN, 1, 2);

    if (IN(PH_L2_IN)) {
        pg8::Gemm g{XB, (const bf16_t*)(ws + W_L2_IN), M, 6144, 1024}; pg8::StaticOrder S; S.init(M, 6144, G, bx);
        pg8::EpiSsdIn E{(bf16_t*)(ws + WS_ZY), (bf16_t*)(ws + WS_XBC), SSQ, (bf16_t*)(ws + WS_HALO)};
        pg8::gemm_phase<pg8::EpiSsdIn, pg8::StaticOrder, true, true>(L + RING_OFF, g, S, E);
        for (int task = vcu; task < M / 64; task += G)
            misc::ssd_dt_task((misc::lptr)(L + RING_OFF), XB, (const bf16_t*)(ws + WS_WGATE + 65536), SSQ, args.in[16], args.in[17], (float*)(ws + WS_DT), (float*)(ws + WS_ACL), (float*)(ws + WS_TOT), task, tid);
    }
    SEAM(PH_L2_IN);
    if (IN(PH_L2_S2)) {
        for (int u = vcu; u < 1024; u += G) { const int b = u >> 9, c = (u >> 3) & 63, g = u & 7;
            ssd::s2_unit((ssd::lptr)(L + RING_OFF), b, c, g, (bf16_t*)(ws + WS_XBC), (const bf16_t*)(ws + WS_HALO), (const float*)(ws + WS_DT), (const float*)(ws + WS_ACL), (const float*)(ws + WS_TOT), args.in[14], args.in[15],
                         (b == 0 ? (bf16_t*)X : (bf16_t*)(ws + WS_ST1)), (float*)(ws + WS_GT + 131072)); }
        asm volatile("s_waitcnt vmcnt(0) lgkmcnt(0)" ::: "memory"); __syncthreads();
    }
    SEAM(PH_L2_S2);
    if (IN(PH_L2_S3)) { ssd::s3_scan((bf16_t*)X, (bf16_t*)(ws + WS_ST1), (const float*)(ws + WS_GT + 131072), vcu, G); asm volatile("s_waitcnt vmcnt(0)" ::: "memory"); __syncthreads(); }
    SEAM(PH_L2_S3);
    if (IN(PH_L2_S4)) {
        ssd::s4_phase((ssd::lptr)(L + RING_OFF), vcu, G, (const bf16_t*)(ws + WS_XBC), (const float*)(ws + WS_DT), (const float*)(ws + WS_ACL), (const float*)(ws + WS_TOT),
                      (const bf16_t*)X, (const bf16_t*)(ws + WS_ST1), args.in[18], args.in[19], (bf16_t*)(ws + WS_ZY));
    }
    SEAM(PH_L2_S4);
    if (IN(PH_L2_OUT)) { pg8::Gemm g{(const bf16_t*)(ws + WS_ZY), (const bf16_t*)(ws + W_L2_OUT), M, 1024, 2048}; pg8::StaticOrder S; S.init(M, 1024, G, bx);
        pg8::EpiResid<1> E{nullptr, X, XB, SSQ, (LAS float*)(L + 131072)}; pg8::gemm_phase<pg8::EpiResid<1>, pg8::StaticOrder, true, true>(L + RING_OFF, g, S, E); }
    SEAM(PH_L2_OUT);
    FFN_PHASES(PH_L2_GU, PH_L2_DN, W_L2_GU, W_L2_DN, 1, 3);

    CONV_LAYER(PH_L3_IN, PH_L3_MIX, PH_L3_OUT, W_L3_IN, W_L3_OUT, 1, 1);
    FFN_PHASES(PH_L3_GU, PH_L3_DN, W_L3_GU, W_L3_DN, 2, 4);
    if (PROBE_SEG == 8) {
        xcd_barrier(bar);
        if (bx == 0 && wave == 0) { unsigned long long acc_ = 0;
            for (int k = 0; k < PH_COUNT - 1; ++k) if ((PROBE_SKEW >> k) & 1ull) { unsigned long long mx = 0, mn = ~0ull, sm = 0;
                for (int j = 0; j < 4; ++j) { const unsigned long long v = __hip_atomic_load((unsigned long long*)(ws + WS_END) + k * 256 + lane + 64 * j, __ATOMIC_RELAXED, __HIP_MEMORY_SCOPE_AGENT); mx = v > mx ? v : mx; mn = v < mn ? v : mn; sm += v; }
                for (int o = 1; o < 64; o <<= 1) { const unsigned long long a = __shfl_xor(mx, o), b = __shfl_xor(mn, o), c = __shfl_xor(sm, o); mx = a > mx ? a : mx; mn = b < mn ? b : mn; sm += c; }
                acc_ += (PROBE_SKEWSTAT == 0) ? mx - sm / 256ull : mx - mn; }
            pr_seg = acc_; } }
    if ((PROBE_MASK != 0ull || PROBE_SEG != 0) && bx == 0 && tid == 0) { if (PROBE_SEG == 5 || PROBE_SEG == 6) pr_seg = *(LAS unsigned long long*)(L + LDSCTL_OFF + 64); const unsigned long long mult_ = (PROBE_SEG >= 5 && PROBE_SEG != 8) ? (PROBE_SEG == 7 ? 2ull : 1ull) : 4ull;
        const unsigned long long t0_ = __builtin_amdgcn_s_memrealtime(); while (__builtin_amdgcn_s_memrealtime() - t0_ < PROBE_MULT * pr_acc + mult_ * pr_seg) __builtin_amdgcn_s_sleep(8); }
#undef IN
#undef SEAM
}

extern "C" void kernel_launch(void* const* d_in, const int* in_sizes, int n_in, void* d_out, int out_size, void* d_ws, size_t ws_size, hipStream_t stream) {
    static int grid = 0;
    if (grid == 0) {
        if (n_in != 21 || in_sizes[0] != M * DMODEL || out_size != M * DMODEL || ws_size < WS_END) {
            fprintf(stderr, "kernel_launch: unexpected shapes (n_in %d, in0 %d, out %d, ws %zu < %zu); nothing launched\n", n_in, n_in > 0 ? in_sizes[0] : -1, out_size, ws_size, (size_t)WS_END); grid = -1; return; }
        int dev = 0, cus = 0, per_cu = 0;
        if (hipGetDevice(&dev) != hipSuccess || hipDeviceGetAttribute(&cus, hipDeviceAttributeMultiprocessorCount, dev) != hipSuccess) { grid = -1; return; }
        if (hipFuncSetAttribute((const void*)mega_fwd, hipFuncAttributeMaxDynamicSharedMemorySize, LDS_BYTES) != hipSuccess) { fprintf(stderr, "kernel_launch: hipFuncSetAttribute failed\n"); grid = -1; return; }
        if (hipOccupancyMaxActiveBlocksPerMultiprocessor(&per_cu, (const void*)mega_fwd, NWAVES * 64, LDS_BYTES) != hipSuccess || per_cu < 1)
            fprintf(stderr, "kernel_launch: note: occupancy query reports %d workgroups per CU\n", per_cu);
        (void)hipGetLastError();
        grid = cus;
    }
    if (grid < 0) return;
    (void)hipMemsetAsync((char*)d_ws + WS_CTL, 0, CTL_ZERO_BYTES, stream);
    Args a{};
    for (int i = 0; i < 21; ++i) a.in[i] = (const float*)d_in[i];
    a.out = (float*)d_out; a.ws = (unsigned char*)d_ws;
    if (MK_N_LAUNCHES == 1) { a.ph_lo = 0; a.ph_hi = PH_COUNT; hipLaunchKernelGGL(mega_fwd, dim3(grid), dim3(NWAVES * 64), LDS_BYTES, stream, a); }
    else for (int p = 0; p < PH_COUNT; ++p) { a.ph_lo = p; a.ph_hi = p + 1; hipLaunchKernelGGL(mega_fwd, dim3(grid), dim3(NWAVES * 64), LDS_BYTES, stream, a); }
}
```
